# Optimizing an MI355X kernel written in HIP

```python
import math
import jax
import jax.numpy as jnp
from jax import lax
import numpy as np


D_MODEL = 2048
BATCH = 1
SEQ = 16384
DEPTH = 4

CHUNK = 64
Q_BLOCK = 128
ROPE_THETA = 10000.0
EPS = 1e-6
NEG = -1e30

A_HEAD_DIM = 128
A_WIDTH = D_MODEL // 4
A_HEADS = A_WIDTH // A_HEAD_DIM
IDX_HEADS = 8
IDX_DIM = 64
TOPK_MAX = 256

S5_GROUP = 16
S5_WIDTH = D_MODEL // 4
S5_GROUPS = S5_WIDTH // S5_GROUP
S5_STATE = 64
S5_DT_MIN = 0.001
S5_DT_MAX = 0.1

C_QK_DIM = 64
C_V_DIM = 2 * C_QK_DIM
C_WIDTH = D_MODEL // 2
C_HEADS = C_WIDTH // C_V_DIM

MIX_WIDTH = A_WIDTH + S5_WIDTH + C_WIDTH
IN_WIDTHS = (A_WIDTH, A_WIDTH, A_WIDTH, IDX_HEADS * IDX_DIM, IDX_DIM, IDX_HEADS, S5_WIDTH, 2 * C_HEADS * C_QK_DIM, 2 * C_HEADS * C_QK_DIM, C_HEADS * C_V_DIM)
IN_WIDTH = 3 * A_WIDTH + IDX_HEADS * IDX_DIM + IDX_DIM + IDX_HEADS + S5_WIDTH + 4 * C_HEADS * C_QK_DIM + C_HEADS * C_V_DIM

MEM_TOKENS = 256
X_HEADS = 4
X_HEAD_DIM = D_MODEL // X_HEADS
D_FF = 4 * D_MODEL

kernel_name = 'hybrid_dsa_s5_diffattn_encoder'


def _rmsnorm(x, g):
    xf = x.astype(jnp.float32)
    xf = xf * lax.rsqrt(jnp.mean(xf * xf, axis=-1, keepdims=True) + EPS)
    return (xf * g.astype(jnp.float32)).astype(x.dtype)


def _rope_tables(L, dim):
    inv = ROPE_THETA ** (-jnp.arange(0, dim, 2, dtype=jnp.float32) / dim)
    ang = jnp.arange(L, dtype=jnp.float32)[:, None] * inv[None, :]
    return jnp.cos(ang), jnp.sin(ang)


def _rope(t, cos, sin):
    shape = (1, cos.shape[0]) + (1,) * (t.ndim - 3) + (cos.shape[1],)
    c = cos.reshape(shape).astype(t.dtype)
    s = sin.reshape(shape).astype(t.dtype)
    t1, t2 = jnp.split(t, 2, axis=-1)
    return jnp.concatenate([t1 * c - t2 * s, t1 * s + t2 * c], axis=-1)


def _split_columns(proj):
    outs, start = [], 0
    for w in IN_WIDTHS:
        outs.append(proj[..., start:start + w])
        start += w
    return outs


def _to_blocks(t):
    B, L = t.shape[:2]
    t = t.reshape((B, L // Q_BLOCK, Q_BLOCK) + t.shape[2:])
    return jnp.moveaxis(t, 1, 0)


def _from_blocks(t):
    t = jnp.moveaxis(t, 0, 1)
    return t.reshape((t.shape[0], t.shape[1] * t.shape[2]) + t.shape[3:])


def _dsa_mixer(q, k, v, q_idx, k_idx, w_idx):
    B, L = q.shape[:2]
    top_k = min(TOPK_MAX, L // 4)
    key_chunk = jnp.arange(L) // CHUNK
    bidx = jnp.arange(B)[:, None, None]
    k_idx_f = k_idx.astype(jnp.float32)

    def block(args):
        qb, qib, wb, qpos = args
        q_chunk = qpos // CHUNK
        allowed = key_chunk[None, :] <= q_chunk[:, None]
        dots = jnp.einsum('bqhd,bkd->bqhk', qib.astype(jnp.float32), k_idx_f) * (IDX_DIM ** -0.5)
        score = jnp.einsum('bqh,bqhk->bqk', wb.astype(jnp.float32) * (IDX_HEADS ** -0.5), jax.nn.relu(dots))
        score = jnp.where(allowed[None], score, NEG)
        _, sel = lax.top_k(score, top_k)
        valid = (sel // CHUNK) <= q_chunk[None, :, None]
        k_sel = k[bidx, sel]
        v_sel = v[bidx, sel]
        s = jnp.einsum('bqhd,bqkhd->bhqk', qb, k_sel).astype(jnp.float32) * (A_HEAD_DIM ** -0.5)
        s = jnp.where(valid[:, None], s, NEG)
        p = jax.nn.softmax(s, axis=-1).astype(v.dtype)
        return jnp.einsum('bhqk,bqkhd->bqhd', p, v_sel)

    qpos = jnp.arange(L).reshape(L // Q_BLOCK, Q_BLOCK)
    out = lax.map(block, (_to_blocks(q), _to_blocks(q_idx), _to_blocks(w_idx), qpos))
    return _from_blocks(out)


def _s5_mixer(u, a_re, a_im, log_dt, b_re, b_im, c_re, c_im, d_skip, w_glu, b_glu):
    f32 = jnp.float32
    B, L = u.shape[:2]
    uf = u.astype(f32).reshape(B, L, S5_GROUPS, S5_GROUP)
    a_re = a_re.astype(f32)
    a_im = a_im.astype(f32)
    dt = jnp.exp(log_dt.astype(f32))[:, None]
    mag = jnp.exp(a_re * dt)
    lb_re = mag * jnp.cos(a_im * dt)
    lb_im = mag * jnp.sin(a_im * dt)
    den = a_re * a_re + a_im * a_im
    f_re = ((lb_re - 1.0) * a_re + lb_im * a_im) / den
    f_im = (lb_im * a_re - (lb_re - 1.0) * a_im) / den
    b_re = b_re.astype(f32)
    b_im = b_im.astype(f32)
    bb_re = f_re[..., None] * b_re - f_im[..., None] * b_im
    bb_im = f_re[..., None] * b_im + f_im[..., None] * b_re
    bu_re = jnp.einsum('gnp,blgp->blgn', bb_re, uf)
    bu_im = jnp.einsum('gnp,blgp->blgn', bb_im, uf)
    al_re = jnp.broadcast_to(lb_re, bu_re.shape)
    al_im = jnp.broadcast_to(lb_im, bu_im.shape)

    def combine(e1, e2):
        a1r, a1i, b1r, b1i = e1
        a2r, a2i, b2r, b2i = e2
        return (a2r * a1r - a2i * a1i,
                a2r * a1i + a2i * a1r,
                a2r * b1r - a2i * b1i + b2r,
                a2r * b1i + a2i * b1r + b2i)

    _, _, x_re, x_im = lax.associative_scan(combine, (al_re, al_im, bu_re, bu_im), axis=1)
    y = (jnp.einsum('gpn,blgn->blgp', c_re.astype(f32), x_re)
         - jnp.einsum('gpn,blgn->blgp', c_im.astype(f32), x_im)
         + d_skip.astype(f32) * uf)
    y = jax.nn.gelu(y.reshape(B, L, S5_WIDTH))
    y = y * jax.nn.sigmoid(y @ w_glu.astype(f32) + b_glu.astype(f32))
    return y.astype(u.dtype)


def _diff_mixer(q, k, v, lam, sub_gain, lam_init):
    B, L = q.shape[:2]
    q = q.reshape(B, L, C_HEADS, 2, C_QK_DIM)
    k = k.reshape(B, L, C_HEADS, 2, C_QK_DIM)
    key_chunk = jnp.arange(L) // CHUNK

    def block(args):
        qb, qpos = args
        allowed = key_chunk[None, :] <= (qpos // CHUNK)[:, None]
        s = jnp.einsum('bqhcd,bkhcd->bchqk', qb, k).astype(jnp.float32) * (C_QK_DIM ** -0.5)
        s = jnp.where(allowed, s, NEG)
        p = jax.nn.softmax(s, axis=-1)
        diff = (p[:, 0] - lam * p[:, 1]).astype(v.dtype)
        return jnp.einsum('bhqk,bkhd->bqhd', diff, v)

    qpos = jnp.arange(L).reshape(L // Q_BLOCK, Q_BLOCK)
    o = _from_blocks(lax.map(block, (_to_blocks(q), qpos)))
    o = _rmsnorm(o, sub_gain) * (1.0 - lam_init)
    return o.reshape(B, L, C_WIDTH)


def _cross_attn(h, mem_n, wq, wk, wv, wo):
    B, L = h.shape[:2]
    M = mem_n.shape[1]
    q = (h @ wq).reshape(B, L, X_HEADS, X_HEAD_DIM)
    k = (mem_n @ wk).reshape(B, M, X_HEADS, X_HEAD_DIM)
    v = (mem_n @ wv).reshape(B, M, X_HEADS, X_HEAD_DIM)
    s = jnp.einsum('bqhd,bkhd->bhqk', q, k).astype(jnp.float32) * (X_HEAD_DIM ** -0.5)
    p = jax.nn.softmax(s, axis=-1).astype(h.dtype)
    o = jnp.einsum('bhqk,bkhd->bqhd', p, v).reshape(B, L, D_MODEL)
    return o @ wo


def setup_inputs(seed: int = 0) -> dict:
    key = jax.random.key(seed)
    ks = jax.random.split(key, 32)
    f32 = jnp.float32
    G, N, P = S5_GROUPS, S5_STATE, S5_GROUP

    def nrm(k, shape, scale):
        return scale * jax.random.normal(k, shape, f32)

    def gain(k, shape):
        return 1.0 + 0.01 * jax.random.normal(k, shape, f32)

    return {
        'x': nrm(ks[0], (BATCH, SEQ, D_MODEL), 1.0),
        'mem': nrm(ks[1], (BATCH, MEM_TOKENS, D_MODEL), 1.0),
        'norm_mix': gain(ks[2], (DEPTH, D_MODEL)),
        'w_in': nrm(ks[3], (DEPTH, D_MODEL, IN_WIDTH), D_MODEL ** -0.5),
        's5_a_re': -0.5 + nrm(ks[4], (DEPTH, G, N), 0.01),
        's5_a_im': math.pi * jnp.arange(N, dtype=f32) + nrm(ks[5], (DEPTH, G, N), 0.01),
        's5_log_dt': jax.random.uniform(ks[6], (DEPTH, G), f32, math.log(S5_DT_MIN), math.log(S5_DT_MAX)),
        's5_b_re': nrm(ks[7], (DEPTH, G, N, P), (2 * P) ** -0.5),
        's5_b_im': nrm(ks[8], (DEPTH, G, N, P), (2 * P) ** -0.5),
        's5_c_re': nrm(ks[9], (DEPTH, G, P, N), N ** -0.5),
        's5_c_im': nrm(ks[10], (DEPTH, G, P, N), N ** -0.5),
        's5_d': nrm(ks[11], (DEPTH, G, P), 1.0),
        's5_w_glu': nrm(ks[12], (DEPTH, S5_WIDTH, S5_WIDTH), S5_WIDTH ** -0.5),
        's5_b_glu': nrm(ks[13], (DEPTH, S5_WIDTH), 0.01),
        'diff_lam_q1': nrm(ks[14], (DEPTH, C_QK_DIM), 0.1),
        'diff_lam_k1': nrm(ks[15], (DEPTH, C_QK_DIM), 0.1),
        'diff_lam_q2': nrm(ks[16], (DEPTH, C_QK_DIM), 0.1),
        'diff_lam_k2': nrm(ks[17], (DEPTH, C_QK_DIM), 0.1),
        'diff_subln': gain(ks[18], (DEPTH, C_V_DIM)),
        'w_out': nrm(ks[19], (DEPTH, MIX_WIDTH, D_MODEL), MIX_WIDTH ** -0.5),
        'norm_xattn': gain(ks[20], (DEPTH, D_MODEL)),
        'norm_mem': gain(ks[21], (DEPTH, D_MODEL)),
        'xattn_q': nrm(ks[22], (DEPTH, D_MODEL, D_MODEL), D_MODEL ** -0.5),
        'xattn_k': nrm(ks[23], (DEPTH, D_MODEL, D_MODEL), D_MODEL ** -0.5),
        'xattn_v': nrm(ks[24], (DEPTH, D_MODEL, D_MODEL), D_MODEL ** -0.5),
        'xattn_o': nrm(ks[25], (DEPTH, D_MODEL, D_MODEL), D_MODEL ** -0.5),
        'norm_mlp': gain(ks[26], (DEPTH, D_MODEL)),
        'w_ff1': nrm(ks[27], (DEPTH, D_MODEL, D_FF), D_MODEL ** -0.5),
        'w_ff2': nrm(ks[28], (DEPTH, D_FF, D_MODEL), D_FF ** -0.5),
        'norm_final': gain(ks[29], (D_MODEL,)),
    }


def reference(x, mem, norm_mix, w_in, s5_a_re, s5_a_im, s5_log_dt, s5_b_re, s5_b_im, s5_c_re, s5_c_im, s5_d, s5_w_glu, s5_b_glu, diff_lam_q1, diff_lam_k1, diff_lam_q2, diff_lam_k2, diff_subln, w_out, norm_xattn, norm_mem, xattn_q, xattn_k, xattn_v, xattn_o, norm_mlp, w_ff1, w_ff2, norm_final):
    f32 = jnp.float32
    B, L, _ = x.shape
    cos_a, sin_a = _rope_tables(L, A_HEAD_DIM)
    cos_i, sin_i = _rope_tables(L, IDX_DIM)
    cos_c, sin_c = _rope_tables(L, C_QK_DIM)
    for l in range(DEPTH):
        h = _rmsnorm(x, norm_mix[l])
        q_a, k_a, v_a, q_i, k_i, w_i, u_s, q_c, k_c, v_c = _split_columns(h @ w_in[l])

        q_a = _rope(q_a.reshape(B, L, A_HEADS, A_HEAD_DIM), cos_a, sin_a)
        k_a = _rope(k_a.reshape(B, L, A_HEADS, A_HEAD_DIM), cos_a, sin_a)
        v_a = v_a.reshape(B, L, A_HEADS, A_HEAD_DIM)
        q_i = _rope(q_i.reshape(B, L, IDX_HEADS, IDX_DIM), cos_i, sin_i)
        k_i = _rope(k_i, cos_i, sin_i)
        o_a = _dsa_mixer(q_a, k_a, v_a, q_i, k_i, w_i).reshape(B, L, A_WIDTH)

        o_s = _s5_mixer(u_s, s5_a_re[l], s5_a_im[l], s5_log_dt[l], s5_b_re[l], s5_b_im[l], s5_c_re[l], s5_c_im[l], s5_d[l], s5_w_glu[l], s5_b_glu[l])

        q_c = _rope(q_c.reshape(B, L, 2 * C_HEADS, C_QK_DIM), cos_c, sin_c)
        k_c = _rope(k_c.reshape(B, L, 2 * C_HEADS, C_QK_DIM), cos_c, sin_c)
        v_c = v_c.reshape(B, L, C_HEADS, C_V_DIM)
        lam_init = 0.8 - 0.6 * math.exp(-0.3 * l)
        lam = (jnp.exp(jnp.sum(diff_lam_q1[l].astype(f32) * diff_lam_k1[l].astype(f32)))
               - jnp.exp(jnp.sum(diff_lam_q2[l].astype(f32) * diff_lam_k2[l].astype(f32)))
               + lam_init)
        o_c = _diff_mixer(q_c, k_c, v_c, lam, diff_subln[l], lam_init)

        x = x + jnp.concatenate([o_a, o_s, o_c], axis=-1) @ w_out[l]

        x = x + _cross_attn(_rmsnorm(x, norm_xattn[l]), _rmsnorm(mem, norm_mem[l]), xattn_q[l], xattn_k[l], xattn_v[l], xattn_o[l])

        h = _rmsnorm(x, norm_mlp[l])
        x = x + jnp.square(jax.nn.relu(h @ w_ff1[l])) @ w_ff2[l]
    return _rmsnorm(x, norm_final)
```

```cpp
#include <hip/hip_runtime.h>
#include <hip/hip_bf16.h>
#include <cstdio>
#include <cstdint>
#include <cmath>

#ifndef EPI_REPS
#define EPI_REPS 1
#endif
#ifndef EPI_KIND
#define EPI_KIND 0
#endif
#define GAS __attribute__((address_space(1)))
#define LAS __attribute__((address_space(3)))

constexpr int L = 16384, DM = 2048, DEPTH = 4, NIN = 5704, NINP = 5888, DFF = 8192, MEMT = 256;
constexpr float EPS = 1e-6f;
constexpr float LOG2E = 1.4426950408889634f;
constexpr float SCL_A = 0.08838834764831845f * LOG2E;
constexpr float SCL_C = 0.125f * LOG2E;
constexpr float SCL_X = 0.04419417382415922f * LOG2E;
constexpr float CIDX = 0.125f * 0.35355339059327373f;

typedef unsigned short bf16_t;
typedef short bf16x8 __attribute__((ext_vector_type(8)));
typedef short s16x4 __attribute__((ext_vector_type(4)));
typedef float f32x4 __attribute__((ext_vector_type(4)));
typedef float f32x2 __attribute__((ext_vector_type(2)));
typedef float f32x16 __attribute__((ext_vector_type(16)));
typedef unsigned u32x4 __attribute__((ext_vector_type(4)));
typedef unsigned u32x2 __attribute__((ext_vector_type(2)));

__device__ __forceinline__ unsigned cvt_pk_bf16(float lo, float hi) { unsigned r; asm volatile("v_cvt_pk_bf16_f32 %0, %1, %2" : "=v"(r) : "v"(lo), "v"(hi)); return r; }
__device__ __forceinline__ float bf2f(unsigned short b) { return __uint_as_float(((unsigned)b) << 16); }
__device__ __forceinline__ float bflo(unsigned w) { return __uint_as_float(w << 16); }
__device__ __forceinline__ float bfhi(unsigned w) { return __uint_as_float(w & 0xffff0000u); }
__device__ __forceinline__ u32x4 pack8(f32x4 a, f32x4 b) { u32x4 w; w.x = cvt_pk_bf16(a[0], a[1]); w.y = cvt_pk_bf16(a[2], a[3]); w.z = cvt_pk_bf16(b[0], b[1]); w.w = cvt_pk_bf16(b[2], b[3]); return w; }

__device__ __forceinline__ int tid_of(int w0) { return (w0 << 6) | (int)__builtin_amdgcn_mbcnt_hi(~0u, __builtin_amdgcn_mbcnt_lo(~0u, 0u)); }

namespace pg8 {
constexpr int BM = 256, BK = 64, HALF = 128, HTB = HALF * BK * 2, STAGE_BYTES = 8 * HTB, NXCD = 8, WGM = 8;
__host__ __device__ __forceinline__ int lds_byte(int r, int c) { const int st = (r >> 4) * 2 + (c >> 5), rr = r & 15, cc = c & 31, ob = rr * 64 + cc * 2; return st * 1024 + (ob ^ (((ob >> 9) & 1) << 5)); }
__host__ __device__ __forceinline__ void stage_rc(int b, int& R, int& C) { const int st = b / 1024, sb = b % 1024, swz = sb ^ (((sb >> 9) & 1) << 5); R = (st >> 1) * 16 + swz / 64; C = (st & 1) * 32 + (swz % 64) / 2; }
__host__ __device__ __forceinline__ int perm32(int rho) { const int n = rho >> 4, i = rho & 15; return 8 * (i >> 2) + 4 * n + (i & 3); }

struct Unit { int pm, pn, z; const char* a; const char* b; };
struct Sched {
    const char* A; const char* B; long sAz, sBz; int lda, ldb;
    int nM, nN, nZ, G, c;
    int cnt = 0, pm0 = 0, pn0 = 0, z0 = 0, lm = 0;
    __device__ __forceinline__ bool next(int i, Unit& u) const {
        const long Lu = (long)i * G + c; const int per = nM * nN; if (cnt > 0 ? i >= cnt : Lu >= (long)per * nZ) return false;
        int pm, pn, z;
        if (cnt > 0) { pm = lm ? pm0 + i : pm0; pn = lm ? pn0 : pn0 + i; z = z0; }
        else if (nZ == 1) {
            const int nwg = per; int wgid = (int)Lu; { const int q = nwg / NXCD, r = nwg % NXCD, xcd = wgid % NXCD, off = wgid / NXCD; wgid = (xcd < r ? xcd * (q + 1) : r * (q + 1) + (xcd - r) * q) + off; }
            const int nig = WGM * nN, gid = wgid / nig, fm = gid * WGM, gsz = (nM - fm) < WGM ? (nM - fm) : WGM;
            pm = fm + ((wgid % nig) % gsz); pn = (wgid % nig) / gsz; z = 0;
        } else { z = (int)(Lu / per); const int w = (int)(Lu % per); pm = w / nN; pn = w % nN; }
        u.pm = pm; u.pn = pn; u.z = z;
        u.a = A + (size_t)z * sAz + (size_t)pm * (size_t)(BM * 2) * lda; u.b = B + (size_t)z * sBz + (size_t)pn * (size_t)(BM * 2) * ldb;
        return true;
    }
};

typedef f32x4 Acc[2][2][4][2];
__device__ __forceinline__ float sum_x16(float x) { auto r = __builtin_amdgcn_permlane16_swap(__float_as_uint(x), __float_as_uint(x), false, false); return __uint_as_float(r[0]) + __uint_as_float(r[1]); }
__device__ __forceinline__ float sum_x32(float x) { auto r = __builtin_amdgcn_permlane32_swap(__float_as_uint(x), __float_as_uint(x), false, false); return __uint_as_float(r[0]) + __uint_as_float(r[1]); }
__device__ __forceinline__ float max_x16(float x) { auto r = __builtin_amdgcn_permlane16_swap(__float_as_uint(x), __float_as_uint(x), false, false); return fmaxf(__uint_as_float(r[0]), __uint_as_float(r[1])); }
__device__ __forceinline__ float max_x32(float x) { auto r = __builtin_amdgcn_permlane32_swap(__float_as_uint(x), __float_as_uint(x), false, false); return fmaxf(__uint_as_float(r[0]), __uint_as_float(r[1])); }
#define EPI_ROWS(ai, m) (u.pm * BM + (ai) * HALF + wr * 64 + (m) * 16 + fr)
#define FOR_AI_M _Pragma("unroll") for (int ai = 0; ai < 2; ++ai) _Pragma("unroll") for (int m = 0; m < 4; ++m)

__device__ __forceinline__ void rope8(f32x4& v0, f32x4& v1, const f32x4 t0, const f32x4 t1) {
    const float a0 = v0[0] * t0[0] - v0[1] * t0[1], a1 = v0[0] * t0[1] + v0[1] * t0[0];
    const float a2 = v0[2] * t0[2] - v0[3] * t0[3], a3 = v0[2] * t0[3] + v0[3] * t0[2];
    const float b0 = v1[0] * t1[0] - v1[1] * t1[1], b1 = v1[0] * t1[1] + v1[1] * t1[0];
    const float b2 = v1[2] * t1[2] - v1[3] * t1[3], b3 = v1[2] * t1[3] + v1[3] * t1[2];
    v0 = (f32x4){a0, a1, a2, a3}; v1 = (f32x4){b0, b1, b2, b3};
}


__device__ __forceinline__ float ssq32(const float* p) {
    float s = 0.f;
#pragma unroll
    for (int i = 0; i < 8; ++i) { const f32x4 v = *(const f32x4*)(p + 4 * i); s += (v[0] + v[1]) + (v[2] + v[3]); }
    return s;
}
__device__ __forceinline__ float row_rstd(const float* ssqp, int row) { return __builtin_amdgcn_rsqf(ssq32(ssqp + (size_t)row * 32) * (1.0f / DM) + EPS); }
__device__ __forceinline__ void rstd_table(const float* ssqp, int row0, LAS float* tab, int wr, int wc, int fr, int fq) {
    const int t = (wr * 4 + wc) * 64 + fq * 16 + fr, row = t >> 1, half = t & 1;
    const float* p = ssqp + (size_t)(row0 + row) * 32 + half * 16; float s = 0.f;
#pragma unroll
    for (int i = 0; i < 4; ++i) { const f32x4 v = *(const f32x4*)(p + 4 * i); s += (v[0] + v[1]) + (v[2] + v[3]); }
    s += __shfl_xor(s, 1);
    if (!half) tab[row] = __builtin_amdgcn_rsqf(s * (1.0f / DM) + EPS);
    asm volatile("s_waitcnt lgkmcnt(0)" ::: "memory"); __builtin_amdgcn_s_barrier(); asm volatile("" ::: "memory");
}
struct EpiInProj {
    static constexpr bool PERM = true, AFTER_DRAIN = false, IDEM = (EPI_KIND == 0 || EPI_KIND == 2);
    const float* ssq; const float* rope128; const float* rope64;
    bf16_t *QA, *KA, *VA, *QI, *KI, *S5A, *QC, *KC, *VC; float* WI; LAS float* tab; float* kmaxp;
    __device__ __forceinline__ void operator()(Acc& acc, const Unit& u, int wr, int wc, int fr, int fq) const {
        const int pn = u.pn;
        bf16_t* dst = QA; int ld = 512, cb = 0, mode = 0;
        if (pn < 2) { dst = QA; cb = pn * 256; mode = 2; }
        else if (pn < 4) { dst = KA; cb = (pn - 2) * 256; mode = 2; }
        else if (pn < 6) { dst = VA; cb = (pn - 4) * 256; mode = 0; }
        else if (pn < 8) { dst = QI; cb = (pn - 6) * 256; mode = 1; }
        else if (pn == 8) { dst = KI; ld = 64; cb = 0; mode = 3; }
        else if (pn < 11) { dst = S5A; cb = (pn - 9) * 256; mode = 4; }
        else if (pn < 15) { dst = QC; ld = 1024; cb = (pn - 11) * 256; mode = 1; }
        else if (pn < 19) { dst = KC; ld = 1024; cb = (pn - 15) * 256; mode = 1; }
        else { dst = VC; ld = 1024; cb = (pn - 19) * 256; mode = 0; }
        rstd_table(ssq, u.pm * BM, tab, wr, wc, fr, fq);
        const int kslot = (pn >= 15 && pn < 19) ? (pn - 15) * 4 : ((pn >= 2 && pn < 4) ? 16 + (pn - 2) * 2 : -1);
        float kmx0 = 0.f, kmx1 = 0.f;
        FOR_AI_M {
            const int row = EPI_ROWS(ai, m);
            const float rs = tab[ai * HALF + wr * 64 + m * 16 + fr];
#pragma unroll
            for (int bj = 0; bj < 2; ++bj) {
                const int cl = cb + bj * HALF + wc * 32 + 8 * fq;
                f32x4 v0 = acc[ai][bj][m][0] * rs, v1 = acc[ai][bj][m][1] * rs;
                if (mode == 3) {
                    if (cl < 64) { const float* tp = rope64 + ((size_t)row * 32 + (cl >> 1)) * 2; rope8(v0, v1, *(const f32x4*)tp, *(const f32x4*)(tp + 4));
                        *(u32x4*)(KI + (size_t)row * 64 + cl) = pack8(v0, v1); }
                    else if (cl == 64) { *(f32x4*)(WI + (size_t)row * 8) = v0 * CIDX; *(f32x4*)(WI + (size_t)row * 8 + 4) = v1 * CIDX; }
                } else if (mode == 4) {
                    const int g = cl >> 4, p0 = cl & 15, j = row >> 4, s = row & 15;
                    *(u32x4*)(S5A + ((size_t)(g * 1024 + j) * 384) + s * 16 + p0) = pack8(v0, v1);
                } else {
                    if (mode == 1) { const float* tp = rope64 + ((size_t)row * 32 + ((cl & 63) >> 1)) * 2; rope8(v0, v1, *(const f32x4*)tp, *(const f32x4*)(tp + 4)); }
                    else if (mode == 2) { const float* tp = rope128 + ((size_t)row * 64 + ((cl & 127) >> 1)) * 2; rope8(v0, v1, *(const f32x4*)tp, *(const f32x4*)(tp + 4)); }
                    *(u32x4*)(dst + (size_t)row * ld + cl) = pack8(v0, v1);
                    if (kslot >= 0) { float ss = (v0[0] * v0[0] + v0[1] * v0[1]) + (v0[2] * v0[2] + v0[3] * v0[3]) + (v1[0] * v1[0] + v1[1] * v1[1]) + (v1[2] * v1[2] + v1[3] * v1[3]);
                        ss = sum_x16(ss); ss = sum_x32(ss); if (bj == 0) kmx0 = fmaxf(kmx0, ss); else kmx1 = fmaxf(kmx1, ss); }
                }
            }
        }
        if (kslot >= 0) {
#pragma unroll
            for (int o = 1; o < 16; o <<= 1) { kmx0 = fmaxf(kmx0, __shfl_xor(kmx0, o)); kmx1 = fmaxf(kmx1, __shfl_xor(kmx1, o)); }
            if (fr == 0 && fq == 0) { const int s0 = kslot < 16 ? kslot + (wc >> 1) : kslot, s1 = kslot < 16 ? kslot + 2 + (wc >> 1) : kslot + 1;
                const int ix = kslot < 16 ? u.pm * 4 + wr * 2 + (wc & 1) : u.pm * 8 + wr * 4 + wc;
                kmaxp[s0 * 512 + ix] = kmx0; kmaxp[s1 * 512 + ix] = kmx1; }
        }
    }
};

struct EpiResid {
    static constexpr bool PERM = true, AFTER_DRAIN = false, IDEM = false;
    bf16_t* xb; float* ssq_next;
    __device__ __forceinline__ void operator()(Acc& acc, const Unit& u, int wr, int wc, int fr, int fq) const {
        FOR_AI_M {
            const int row = EPI_ROWS(ai, m); float sq = 0.f;
#pragma unroll
            for (int bj = 0; bj < 2; ++bj) {
                const size_t off = (size_t)row * DM + u.pn * BM + bj * HALF + wc * 32 + 8 * fq;
                const u32x4 xw = *(const u32x4*)(xb + off);
                const f32x4 a0 = acc[ai][bj][m][0], a1 = acc[ai][bj][m][1];
                const u32x4 w = pack8((f32x4){bflo(xw.x) + a0[0], bfhi(xw.x) + a0[1], bflo(xw.y) + a0[2], bfhi(xw.y) + a0[3]}, (f32x4){bflo(xw.z) + a1[0], bfhi(xw.z) + a1[1], bflo(xw.w) + a1[2], bfhi(xw.w) + a1[3]});
                *(u32x4*)(xb + off) = w;
                const float v0 = bflo(w.x), v1 = bfhi(w.x), v2 = bflo(w.y), v3 = bfhi(w.y), v4 = bflo(w.z), v5 = bfhi(w.z), v6 = bflo(w.w), v7 = bfhi(w.w);
                sq += ((v0 * v0 + v1 * v1) + (v2 * v2 + v3 * v3)) + ((v4 * v4 + v5 * v5) + (v6 * v6 + v7 * v7));
            }
            sq = sum_x16(sq); sq = sum_x32(sq);
            if (fq == 0) ssq_next[(size_t)row * 32 + u.pn * 4 + wc] = sq;
            asm volatile("" ::: "memory");
        }
    }
};

template <int ACT> struct EpiRowBf16 {
    static constexpr bool PERM = true, AFTER_DRAIN = false, IDEM = (EPI_KIND == 0 || EPI_KIND == 1);
    const float* ssq; bf16_t* O; int ldc; int zcols; LAS float* tab;
    __device__ __forceinline__ void operator()(Acc& acc, const Unit& u, int wr, int wc, int fr, int fq) const {
        if (ssq) rstd_table(ssq, u.pm * BM, tab, wr, wc, fr, fq);
        FOR_AI_M {
            const int row = EPI_ROWS(ai, m);
            const float rs = ssq ? tab[ai * HALF + wr * 64 + m * 16 + fr] : 1.0f;
#pragma unroll
            for (int bj = 0; bj < 2; ++bj) {
                f32x4 v0 = acc[ai][bj][m][0] * rs, v1 = acc[ai][bj][m][1] * rs;
                if (ACT == 1) {
#pragma unroll
                    for (int e = 0; e < 4; ++e) { const float a = fmaxf(v0[e], 0.f), b = fmaxf(v1[e], 0.f); v0[e] = a * a; v1[e] = b * b; }
                }
                *(u32x4*)(O + (size_t)row * ldc + u.z * zcols + u.pn * BM + bj * HALF + wc * 32 + 8 * fq) = pack8(v0, v1);
            }
        }
    }
};

template <bool COLSCALE> struct EpiMemKV {
    static constexpr bool PERM = true, AFTER_DRAIN = false, IDEM = (EPI_KIND == 0);
    const float* rstd; bf16_t* O; int ldc; long zstride;
    __device__ __forceinline__ void operator()(Acc& acc, const Unit& u, int wr, int wc, int fr, int fq) const {
        FOR_AI_M {
            const int row = EPI_ROWS(ai, m);
#pragma unroll
            for (int bj = 0; bj < 2; ++bj) {
                const int col = u.pn * BM + bj * HALF + wc * 32 + 8 * fq;
                f32x4 v0 = acc[ai][bj][m][0], v1 = acc[ai][bj][m][1];
                if (COLSCALE) { v0 = v0 * *(const f32x4*)(rstd + col); v1 = v1 * *(const f32x4*)(rstd + col + 4); }
                else if (rstd) { const float rs = rstd[row]; v0 = v0 * rs; v1 = v1 * rs; }
                *(u32x4*)(O + (size_t)u.z * zstride + (size_t)row * ldc + col) = pack8(v0, v1);
            }
        }
    }
};

struct EpiS5E {
    static constexpr bool PERM = false, AFTER_DRAIN = false, IDEM = (EPI_KIND == 0);
    float* E;
    __device__ __forceinline__ void operator()(Acc& acc, const Unit& u, int wr, int wc, int fr, int fq) const {
        FOR_AI_M {
            const int row = EPI_ROWS(ai, m);
#pragma unroll
            for (int n = 0; n < 2; ++n) *(f32x4*)(E + ((size_t)u.z * 1024 + row) * 128 + wc * 32 + n * 16 + 4 * fq) = acc[ai][0][m][n];
        }
    }
};

__device__ __forceinline__ float gelu_tanh(float x) {
    const float t = 1.5957691216057308f * (x + 0.044715f * x * x * x);
    return x * __builtin_amdgcn_rcpf(1.0f + __builtin_amdgcn_exp2f(-t * LOG2E));
}
struct EpiS5Y {
    static constexpr bool PERM = true, AFTER_DRAIN = false, IDEM = (EPI_KIND == 0);
    bf16_t* YB;
    __device__ __forceinline__ void operator()(Acc& acc, const Unit& u, int wr, int wc, int fr, int fq) const {
        FOR_AI_M {
            const int j = EPI_ROWS(ai, m);
#pragma unroll
            for (int bj = 0; bj < 2; ++bj) {
                const int col = bj * HALF + wc * 32 + 8 * fq, s = col >> 4, p0 = col & 15;
                f32x4 v0 = acc[ai][bj][m][0], v1 = acc[ai][bj][m][1];
#pragma unroll
                for (int e = 0; e < 4; ++e) { v0[e] = gelu_tanh(v0[e]); v1[e] = gelu_tanh(v1[e]); }
                *(u32x4*)(YB + (size_t)(16 * j + s) * 512 + 16 * u.z + p0) = pack8(v0, v1);
            }
        }
    }
};
struct EpiGLU {
    static constexpr bool PERM = true, AFTER_DRAIN = false, IDEM = (EPI_KIND == 0);
    const bf16_t* YB; const float* bias; bf16_t* CAT;
    __device__ __forceinline__ void operator()(Acc& acc, const Unit& u, int wr, int wc, int fr, int fq) const {
        FOR_AI_M {
            const int row = EPI_ROWS(ai, m);
#pragma unroll
            for (int bj = 0; bj < 2; ++bj) {
                const int col = u.pn * BM + bj * HALF + wc * 32 + 8 * fq;
                const u32x4 yw = *(const u32x4*)(YB + (size_t)row * 512 + col);
                const f32x4 b0 = *(const f32x4*)(bias + col), b1 = *(const f32x4*)(bias + col + 4);
                f32x4 g0 = acc[ai][bj][m][0] + b0, g1 = acc[ai][bj][m][1] + b1;
                const float y[8] = {bflo(yw.x), bfhi(yw.x), bflo(yw.y), bfhi(yw.y), bflo(yw.z), bfhi(yw.z), bflo(yw.w), bfhi(yw.w)};
#pragma unroll
                for (int e = 0; e < 4; ++e) { g0[e] = y[e] * __builtin_amdgcn_rcpf(1.0f + __builtin_amdgcn_exp2f(-g0[e] * LOG2E)); g1[e] = y[4 + e] * __builtin_amdgcn_rcpf(1.0f + __builtin_amdgcn_exp2f(-g1[e] * LOG2E)); }
                *(u32x4*)(CAT + (size_t)row * DM + 512 + col) = pack8(g0, g1);
            }
        }
    }
};
struct EpiSoftmax {
    static constexpr bool PERM = true, AFTER_DRAIN = false, IDEM = false;
    const float* ssq; bf16_t* PX; LAS float* red;
    __device__ __forceinline__ void operator()(Acc& acc, const Unit& u, int wr, int wc, int fr, int fq) const {
        LAS float* red2 = red + 1024;
        rstd_table(ssq, u.pm * BM, red2, wr, wc, fr, fq);
        float rsv[2][4];
        FOR_AI_M {
            const int rt = ai * HALF + wr * 64 + m * 16 + fr; float mx = -3.0e38f; rsv[ai][m] = red2[rt];
#pragma unroll
            for (int bj = 0; bj < 2; ++bj)
#pragma unroll
                for (int n = 0; n < 2; ++n) { const f32x4 v = acc[ai][bj][m][n]; mx = fmaxf(mx, fmaxf(fmaxf(v[0], v[1]), fmaxf(v[2], v[3]))); }
            mx = max_x16(mx); mx = max_x32(mx);
            if (fq == 0) red[rt * 4 + wc] = mx;
        }
        asm volatile("s_waitcnt lgkmcnt(0)" ::: "memory"); __builtin_amdgcn_s_barrier(); asm volatile("" ::: "memory");
        FOR_AI_M {
            const int rt = ai * HALF + wr * 64 + m * 16 + fr; const f32x4 r4 = *(const LAS f32x4*)(red + rt * 4);
            const float mx = fmaxf(fmaxf(r4[0], r4[1]), fmaxf(r4[2], r4[3])); float sm = 0.f;
#pragma unroll
            for (int bj = 0; bj < 2; ++bj)
#pragma unroll
                for (int n = 0; n < 2; ++n) { f32x4 v = acc[ai][bj][m][n];
#pragma unroll
                    for (int e = 0; e < 4; ++e) { v[e] = __builtin_amdgcn_exp2f((v[e] - mx) * rsv[ai][m]); sm += v[e]; }
                    acc[ai][bj][m][n] = v; }
            sm = sum_x16(sm); sm = sum_x32(sm);
            if (fq == 0) red2[rt * 4 + wc] = sm;
        }
        asm volatile("s_waitcnt lgkmcnt(0)" ::: "memory"); __builtin_amdgcn_s_barrier(); asm volatile("" ::: "memory");
        FOR_AI_M {
            const int rt = ai * HALF + wr * 64 + m * 16 + fr; const f32x4 r4 = *(const LAS f32x4*)(red2 + rt * 4);
            const float inv = __builtin_amdgcn_rcpf((r4[0] + r4[1]) + (r4[2] + r4[3]));
            const int row = u.pm * BM + rt;
#pragma unroll
            for (int bj = 0; bj < 2; ++bj)
                *(u32x4*)(PX + (size_t)row * 1024 + u.z * 256 + bj * HALF + wc * 32 + 8 * fq) = pack8(acc[ai][bj][m][0] * inv, acc[ai][bj][m][1] * inv);
        }
    }
};
template <class Epi, bool ALIGN_EPI = true, bool SP2 = true>
__device__ __forceinline__ void gemm_phase(LAS unsigned char* lds, const int K, const Sched& S0, const Epi& E, const int w0) {
    Sched S = S0; { int c_ = S0.c; asm volatile("" : "+s"(c_)); S.c = c_; }
    int tid_ = tid_of(w0); asm volatile("" : "+v"(tid_));
    const int tid = tid_, wid = __builtin_amdgcn_readfirstlane(tid >> 6), lane = tid & 63, wr = wid >> 2, wc = wid & 3, fr = lane & 15, fq = lane >> 4;
    const int nt = K / BK; const int lda = S.lda, ldb = S.ldb;
    unsigned voffA[2], voffB[2];
#pragma unroll
    for (int i = 0; i < 2; ++i) { int R, C; stage_rc(tid * 16 + i * 8192, R, C); const int Rb = Epi::PERM ? ((R & ~31) + perm32(R & 31)) : R;
        voffA[i] = (unsigned)(R * lda + C) * 2u; voffB[i] = (unsigned)(Rb * ldb + C) * 2u; }
    const size_t kstep = (size_t)(BK * 2);
    const size_t hstepA = (size_t)HALF * lda * 2, hstepB = (size_t)HALF * ldb * 2;
    const unsigned ldsw = (unsigned)wid * 1024u;
    const int aoff = lds_byte(wr * 64 + fr, fq * 8), boff = lds_byte(wc * 32 + fr, fq * 8);
#define PG8_SA(b, h) (((b) * 2 + (h)) * HTB)
#define PG8_SB(b, h) ((4 + (b) * 2 + (h)) * HTB)
#define PG8_STAGE(bufoff, gbase, voff) do { _Pragma("unroll") for (int _i = 0; _i < 2; ++_i) \
        __builtin_amdgcn_global_load_lds((const unsigned*)((const char*)(gbase) + (voff)[_i]), (LAS unsigned*)(lds + (bufoff) + ldsw + _i * 8192), 16, 0, 0); } while (0)
#define PG8_LDA(dst, b, h) do { _Pragma("unroll") for (int m = 0; m < 4; ++m) _Pragma("unroll") for (int k = 0; k < 2; ++k) dst[m][k] = *(const LAS bf16x8*)(lds + PG8_SA(b, h) + aoff + m * 2048 + k * 1024); } while (0)
#define PG8_LDB(dst, b, h) do { _Pragma("unroll") for (int n = 0; n < 2; ++n) _Pragma("unroll") for (int k = 0; k < 2; ++k) dst[n][k] = *(const LAS bf16x8*)(lds + PG8_SB(b, h) + boff + n * 2048 + k * 1024); } while (0)
#define PG8_MMA(ai, bj, At, Bt) do { __builtin_amdgcn_s_setprio(1); _Pragma("unroll") for (int m = 0; m < 4; ++m) _Pragma("unroll") for (int n = 0; n < 2; ++n) _Pragma("unroll") for (int k = 0; k < 2; ++k) \
        acc[ai][bj][m][n] = __builtin_amdgcn_mfma_f32_16x16x32_bf16(Bt[n][k], At[m][k], acc[ai][bj][m][n], 0, 0, 0); __builtin_amdgcn_s_setprio(0); } while (0)
#define PG8_WAIT_V(n) asm volatile("s_waitcnt vmcnt(" #n ")" ::: "memory")
#define PG8_WAIT_L(n) asm volatile("s_waitcnt lgkmcnt(" #n ")" ::: "memory")
#define PG8_BAR __builtin_amdgcn_s_barrier()
#define PG8_SCHED __builtin_amdgcn_sched_barrier(0)
    Unit cur, nxt; int ui = 0;
    if (!S.next(0, cur)) return;
    f32x4 acc[2][2][4][2];
#pragma unroll
    for (int a = 0; a < 2; ++a)
#pragma unroll
        for (int b = 0; b < 2; ++b)
#pragma unroll
            for (int m = 0; m < 4; ++m)
#pragma unroll
                for (int n = 0; n < 2; ++n) acc[a][b][m][n] = (f32x4){0.f, 0.f, 0.f, 0.f};
    bf16x8 At[4][2], B0[2][2], B1[2][2];
    const char* cA = cur.a; const char* cB = cur.b;
    if constexpr (SP2) {
        PG8_STAGE(PG8_SB(0, 0), cB, voffB); PG8_STAGE(PG8_SB(0, 1), cB + hstepB, voffB); PG8_STAGE(PG8_SA(0, 0), cA, voffA); PG8_STAGE(PG8_SA(0, 1), cA + hstepA, voffA);
        if (wr == 1) PG8_BAR;
        PG8_WAIT_V(2); PG8_BAR;
        PG8_STAGE(PG8_SB(1, 0), cB + kstep, voffB); PG8_STAGE(PG8_SA(1, 0), cA + kstep, voffA); PG8_STAGE(PG8_SB(1, 1), cB + hstepB + kstep, voffB);
        PG8_WAIT_V(6); PG8_BAR;
    } else {
        PG8_STAGE(PG8_SB(0, 0), cB, voffB); PG8_STAGE(PG8_SA(0, 0), cA, voffA); PG8_STAGE(PG8_SB(0, 1), cB + hstepB, voffB); PG8_STAGE(PG8_SA(0, 1), cA + hstepA, voffA);
        if (wr == 1) PG8_BAR;
        PG8_WAIT_V(4); PG8_BAR;
        PG8_STAGE(PG8_SB(1, 0), cB + kstep, voffB); PG8_STAGE(PG8_SA(1, 0), cA + kstep, voffA); PG8_STAGE(PG8_SB(1, 1), cB + hstepB + kstep, voffB);
        PG8_WAIT_V(6); PG8_BAR;
    }
    for (;;) {
        const bool has_next = S.next(ui + 1, nxt);
        const char* nA = has_next ? nxt.a : cA; const char* nB = has_next ? nxt.b : cB;
#pragma unroll 1
        for (int t = 0; t < nt; t += 2) {
            const bool last = (t == nt - 2);
            const char* a1 = cA + (size_t)(t + 1) * kstep;
            const char* a2 = last ? nA : cA + (size_t)(t + 2) * kstep; const char* b2 = last ? nB : cB + (size_t)(t + 2) * kstep;
            const char* a3 = a2 + kstep; const char* b3 = b2 + kstep;
            if constexpr (SP2) {
            PG8_LDB(B0, 0, 0); PG8_LDB(B1, 0, 1); PG8_SCHED; PG8_LDA(At, 0, 0); PG8_STAGE(PG8_SA(1, 1), a1 + hstepA, voffA);
            PG8_WAIT_V(8); PG8_WAIT_L(0); PG8_BAR; PG8_MMA(0, 0, At, B0); PG8_MMA(0, 1, At, B1); PG8_BAR; PG8_SCHED;
            PG8_LDA(At, 0, 1); PG8_STAGE(PG8_SB(0, 0), b2, voffB); PG8_STAGE(PG8_SB(0, 1), b2 + hstepB, voffB); PG8_STAGE(PG8_SA(0, 0), a2, voffA);
            PG8_WAIT_V(8); PG8_WAIT_L(0); PG8_BAR; PG8_MMA(1, 0, At, B0); PG8_MMA(1, 1, At, B1); PG8_BAR; PG8_SCHED;
            PG8_LDB(B0, 1, 0); PG8_LDB(B1, 1, 1); PG8_SCHED; PG8_LDA(At, 1, 0); PG8_STAGE(PG8_SA(0, 1), a2 + hstepA, voffA);
            PG8_WAIT_V(8); PG8_WAIT_L(0); PG8_BAR; PG8_MMA(0, 0, At, B0); PG8_MMA(0, 1, At, B1); PG8_BAR; PG8_SCHED;
            PG8_LDA(At, 1, 1); PG8_STAGE(PG8_SB(1, 0), b3, voffB); PG8_STAGE(PG8_SB(1, 1), b3 + hstepB, voffB); PG8_STAGE(PG8_SA(1, 0), a3, voffA);
            PG8_WAIT_V(8); PG8_WAIT_L(0); PG8_BAR; PG8_MMA(1, 0, At, B0); PG8_MMA(1, 1, At, B1); PG8_BAR; PG8_SCHED;
            } else {
            PG8_LDB(B0, 0, 0); PG8_SCHED; PG8_LDA(At, 0, 0); PG8_STAGE(PG8_SA(1, 1), a1 + hstepA, voffA);
            PG8_WAIT_L(8); PG8_BAR; PG8_WAIT_L(0); PG8_MMA(0, 0, At, B0); PG8_BAR; PG8_SCHED;
            PG8_LDB(B1, 0, 1); PG8_STAGE(PG8_SB(0, 0), b2, voffB);
            PG8_BAR; PG8_WAIT_L(0); PG8_MMA(0, 1, At, B1); PG8_BAR;
            PG8_LDA(At, 0, 1); PG8_STAGE(PG8_SA(0, 0), a2, voffA);
            PG8_BAR; PG8_WAIT_L(0); PG8_MMA(1, 0, At, B0); PG8_BAR; PG8_SCHED;
            PG8_STAGE(PG8_SB(0, 1), b2 + hstepB, voffB);
            PG8_WAIT_V(6); PG8_BAR; PG8_MMA(1, 1, At, B1); PG8_BAR;
            PG8_LDB(B0, 1, 0); PG8_SCHED; PG8_LDA(At, 1, 0); PG8_STAGE(PG8_SA(0, 1), a2 + hstepA, voffA);
            PG8_WAIT_L(8); PG8_BAR; PG8_WAIT_L(0); PG8_MMA(0, 0, At, B0); PG8_BAR; PG8_SCHED;
            PG8_LDB(B1, 1, 1); PG8_STAGE(PG8_SB(1, 0), b3, voffB);
            PG8_BAR; PG8_WAIT_L(0); PG8_MMA(0, 1, At, B1); PG8_BAR;
            PG8_LDA(At, 1, 1); PG8_STAGE(PG8_SA(1, 0), a3, voffA);
            PG8_BAR; PG8_WAIT_L(0); PG8_MMA(1, 0, At, B0); PG8_BAR; PG8_SCHED;
            PG8_STAGE(PG8_SB(1, 1), b3 + hstepB, voffB);
            PG8_WAIT_V(6); PG8_BAR; PG8_MMA(1, 1, At, B1); PG8_BAR;
            }
        }
        if constexpr (ALIGN_EPI) { if (wr == 0) PG8_BAR; }
        if constexpr (!Epi::AFTER_DRAIN) { _Pragma("unroll 1") for (int er_ = 0; er_ < (Epi::IDEM ? EPI_REPS : 1); ++er_) E(acc, cur, wr, wc, fr, fq); }
        if (!has_next) break;
#pragma unroll
        for (int a = 0; a < 2; ++a)
#pragma unroll
            for (int b = 0; b < 2; ++b)
#pragma unroll
                for (int m = 0; m < 4; ++m)
#pragma unroll
                    for (int n = 0; n < 2; ++n) acc[a][b][m][n] = (f32x4){0.f, 0.f, 0.f, 0.f};
        cur = nxt; cA = nA; cB = nB; ++ui;
        if constexpr (ALIGN_EPI) { if (wr == 1) PG8_BAR; }
    }
    PG8_WAIT_V(0);
    if constexpr (!ALIGN_EPI) { if (wr == 0) PG8_BAR; }
    PG8_BAR;
    if constexpr (Epi::AFTER_DRAIN) { E.fused(acc, cur, wr, wc, fr, fq, lds, wid, lane); }
#undef PG8_SA
#undef PG8_SB
#undef PG8_STAGE
#undef PG8_LDA
#undef PG8_LDB
#undef PG8_MMA
#undef PG8_WAIT_V
#undef PG8_WAIT_L
#undef PG8_BAR
#undef PG8_SCHED
}
}

namespace dattn {
constexpr int NW = 8, QBLK = 32, KVBLK = 64, LDO = 2048;
constexpr float THR = 8.f * 1.4426950408889634f;
constexpr int SHM_V = KVBLK * 128 * 2;
constexpr int STASH_OFF = 77824;
#define KSWZ(row, colB) ((row) * (DQK * 2) + ((colB) ^ ((DQK == 64 ? (((row) >> 1) & 7) : ((row) & 15)) << 4)))
#define SBAR() __builtin_amdgcn_sched_barrier(0)
__device__ __forceinline__ int crow(int r, int hi) { return (r & 3) + 8 * (r >> 2) + 4 * hi; }
template <bool REL>
__device__ __forceinline__ void partialSM(f32x16& p0, f32x16& p1, float& m_reg, float& mn, float& alpha) {
  if (REL) {
#pragma unroll
    for (int r = 0; r < 16; ++r) p0[r] = p0[r] - m_reg;
#pragma unroll
    for (int r = 0; r < 16; ++r) p1[r] = p1[r] - m_reg;
    float pmax = p0[0];
#pragma unroll
    for (int r = 1; r < 16; ++r) pmax = fmaxf(pmax, p0[r]);
#pragma unroll
    for (int r = 0; r < 16; ++r) pmax = fmaxf(pmax, p1[r]);
    { auto rr = __builtin_amdgcn_permlane32_swap(__float_as_uint(pmax), __float_as_uint(pmax), false, false);
      pmax = fmaxf(__uint_as_float(rr[0]), __uint_as_float(rr[1])); }
    if (__builtin_expect(__all(pmax <= THR), 1)) { mn = m_reg; alpha = 1.f; }
    else { const float d = fmaxf(pmax, 0.f); mn = m_reg + d; alpha = __builtin_amdgcn_exp2f(-d); m_reg = mn;
#pragma unroll
      for (int r = 0; r < 16; ++r) { p0[r] = p0[r] - d; p1[r] = p1[r] - d; } }
  } else {
    float pmax = p0[0];
#pragma unroll
    for (int r = 1; r < 16; ++r) pmax = fmaxf(pmax, p0[r]);
#pragma unroll
    for (int r = 0; r < 16; ++r) pmax = fmaxf(pmax, p1[r]);
    { auto rr = __builtin_amdgcn_permlane32_swap(__float_as_uint(pmax), __float_as_uint(pmax), false, false);
      pmax = fmaxf(__uint_as_float(rr[0]), __uint_as_float(rr[1])); }
    if (__builtin_expect(__all(pmax - m_reg <= THR), 1)) { mn = m_reg; alpha = 1.f; }
    else { mn = fmaxf(m_reg, pmax); alpha = __builtin_amdgcn_exp2f(m_reg - mn); m_reg = mn; }
#pragma unroll
    for (int r = 0; r < 16; ++r) p0[r] = p0[r] - mn;
#pragma unroll
    for (int r = 0; r < 16; ++r) p1[r] = p1[r] - mn;
  }
#pragma unroll
  for (int r = 0; r < 16; ++r) p0[r] = __builtin_amdgcn_exp2f(p0[r]);
}
__device__ __forceinline__ void finishSM(f32x16& p0, f32x16& p1, float alpha, float& l_reg, bf16x8& pa0, bf16x8& pa1, bf16x8& pa2, bf16x8& pa3) {
#pragma unroll
  for (int r = 0; r < 16; ++r) p1[r] = __builtin_amdgcn_exp2f(p1[r]);
  float ps = 0;
#pragma unroll
  for (int r = 0; r < 16; ++r) ps += p0[r];
#pragma unroll
  for (int r = 0; r < 16; ++r) ps += p1[r];
  { auto rr = __builtin_amdgcn_permlane32_swap(__float_as_uint(ps), __float_as_uint(ps), false, false);
    ps = __uint_as_float(rr[0]) + __uint_as_float(rr[1]); }
  l_reg = l_reg * alpha + ps;
#define PK4(P, BASE, OUT) do { unsigned a0 = cvt_pk_bf16(P[BASE + 0], P[BASE + 1]), a1 = cvt_pk_bf16(P[BASE + 2], P[BASE + 3]);   \
    unsigned b0 = cvt_pk_bf16(P[BASE + 4], P[BASE + 5]), b1 = cvt_pk_bf16(P[BASE + 6], P[BASE + 7]);                              \
    auto r0 = __builtin_amdgcn_permlane32_swap(a0, b0, false, false); auto r1 = __builtin_amdgcn_permlane32_swap(a1, b1, false, false); \
    u32x4 w = {r0[0], r1[0], r0[1], r1[1]}; OUT = *reinterpret_cast<bf16x8*>(&w); } while (0)
  PK4(p0, 0, pa0); PK4(p0, 8, pa1); PK4(p1, 0, pa2); PK4(p1, 8, pa3);
#undef PK4
}
template <int DQK, bool MASKED, bool FIXM>
__device__ __forceinline__ void qkt(f32x16& p0, f32x16& p1, const char* Ks, const bf16x8* qr, int r32, int hi, bool valid, unsigned w0, unsigned w1, float negb) {
  const unsigned nb = FIXM ? __float_as_uint(negb) : 0u;
  if (MASKED && FIXM) {
    const unsigned na0 = ~(w0 >> (4 * hi)), na1 = ~(w1 >> (4 * hi));
#pragma unroll
    for (int r = 0; r < 16; ++r) { const int bit = (r & 3) + 8 * (r >> 2);
      const int x0 = __builtin_amdgcn_sbfe((int)na0, bit, 1), x1 = __builtin_amdgcn_sbfe((int)na1, bit, 1); unsigned y0, y1;
      asm("v_and_b32 %0, %1, %2" : "=v"(y0) : "s"(0xff800000u), "v"(x0)); asm("v_and_b32 %0, %1, %2" : "=v"(y1) : "s"(0xff800000u), "v"(x1));
      p0[r] = __uint_as_float(y0); p1[r] = __uint_as_float(y1); }
  } else if (MASKED) {
    const unsigned a0 = w0 >> (4 * hi), a1 = w1 >> (4 * hi);
#pragma unroll
    for (int r = 0; r < 16; ++r) { const int bit = (r & 3) + 8 * (r >> 2);
      const unsigned x0 = (unsigned)__builtin_amdgcn_sbfe((int)a0, bit, 1), x1 = (unsigned)__builtin_amdgcn_sbfe((int)a1, bit, 1);
      p0[r] = __uint_as_float((x0 & nb) | (0xff800000u & ~x0));
      p1[r] = __uint_as_float((x1 & nb) | (0xff800000u & ~x1)); }
  } else {
#pragma unroll
    for (int r = 0; r < 16; ++r) { p0[r] = __uint_as_float(nb); p1[r] = __uint_as_float(nb); } }
  if (valid) {
#pragma unroll
    for (int d0 = 0; d0 < DQK / 16; ++d0) { const int cb = (d0 * 16 + hi * 8) * 2;
      bf16x8 b0 = *reinterpret_cast<const bf16x8*>(Ks + KSWZ(r32, cb));
      bf16x8 b1 = *reinterpret_cast<const bf16x8*>(Ks + KSWZ(32 + r32, cb));
      p0 = __builtin_amdgcn_mfma_f32_32x32x16_bf16(b0, qr[d0], p0, 0, 0, 0);
      p1 = __builtin_amdgcn_mfma_f32_32x32x16_bf16(b1, qr[d0], p1, 0, 0, 0); }
  } else {
#pragma unroll
    for (int r = 0; r < 16; ++r) { p0[r] = -INFINITY; p1[r] = -INFINITY; } }
}
template <int DQK, bool FIXM>
__device__ __forceinline__ void qkt_r(f32x16& p0, f32x16& p1, const bf16x8* kf, const char* Ks, const bf16x8* qr, int r32, int hi, bool valid, float negb) {
  const unsigned nb = FIXM ? __float_as_uint(negb) : 0u;
#pragma unroll
  for (int r = 0; r < 16; ++r) { p0[r] = __uint_as_float(nb); p1[r] = __uint_as_float(nb); }
#pragma unroll
  for (int d0 = 0; d0 < DQK / 32; ++d0) {
    p0 = __builtin_amdgcn_mfma_f32_32x32x16_bf16(kf[2 * d0], qr[d0], p0, 0, 0, 0);
    p1 = __builtin_amdgcn_mfma_f32_32x32x16_bf16(kf[2 * d0 + 1], qr[d0], p1, 0, 0, 0); }
#pragma unroll
  for (int d0 = DQK / 32; d0 < DQK / 16; ++d0) { const int cb = (d0 * 16 + hi * 8) * 2;
    bf16x8 b0 = *reinterpret_cast<const bf16x8*>(Ks + KSWZ(r32, cb));
    bf16x8 b1 = *reinterpret_cast<const bf16x8*>(Ks + KSWZ(32 + r32, cb));
    p0 = __builtin_amdgcn_mfma_f32_32x32x16_bf16(b0, qr[d0], p0, 0, 0, 0);
    p1 = __builtin_amdgcn_mfma_f32_32x32x16_bf16(b1, qr[d0], p1, 0, 0, 0); }
  if (!valid) {
#pragma unroll
    for (int r = 0; r < 16; ++r) { p0[r] = -INFINITY; p1[r] = -INFINITY; } }
}
template <int DQK>
__device__ __forceinline__ void kload(bf16x8* kf, const char* Ks, int r32, int hi) {
#pragma unroll
  for (int d0 = 0; d0 < DQK / 32; ++d0) { const int cb = (d0 * 16 + hi * 8) * 2;
    kf[2 * d0] = *reinterpret_cast<const bf16x8*>(Ks + KSWZ(r32, cb)); kf[2 * d0 + 1] = *reinterpret_cast<const bf16x8*>(Ks + KSWZ(32 + r32, cb)); }
#pragma unroll
  for (int i = 0; i < DQK / 16; ++i) asm volatile("" : "+v"(kf[i]));
}
__device__ __forceinline__ int v_st(int k, int c) { const int kk = (k & ~0xC) | ((k & 4) << 1) | ((k & 8) >> 1); return ((kk >> 3) * 4 + (c >> 5)) * 512 + ((kk & 7) * 32 + (c & 31)) * 2; }
__device__ __forceinline__ int v_rd_base(int lane) { return ((lane & 3) << 3) | (((lane >> 2) & 3) << 6) | (((lane >> 4) & 1) << 5) | (((lane >> 5) & 1) << 8); }
constexpr int v_rd_off(int d0, int ks, int half) { return d0 * 512 + ks * 4096 + half * 2048; }
template <int OFF> __device__ __forceinline__ s16x4 tr_read(int vb) {
  s16x4 r; asm volatile("ds_read_b64_tr_b16 %0, %1 offset:%2" : "=&v"(r) : "v"(vb), "i"(OFF) : "memory"); return r;
}
template <int D0> __device__ __forceinline__ void pv_one(f32x16& od, int vb, bf16x8 pa0, bf16x8 pa1, bf16x8 pa2, bf16x8 pa3) {
  const s16x4 l0 = tr_read<v_rd_off(D0, 0, 0)>(vb), h0 = tr_read<v_rd_off(D0, 0, 1)>(vb), l1 = tr_read<v_rd_off(D0, 1, 0)>(vb), h1 = tr_read<v_rd_off(D0, 1, 1)>(vb);
  const s16x4 l2 = tr_read<v_rd_off(D0, 2, 0)>(vb), h2 = tr_read<v_rd_off(D0, 2, 1)>(vb), l3 = tr_read<v_rd_off(D0, 3, 0)>(vb), h3 = tr_read<v_rd_off(D0, 3, 1)>(vb);
  asm volatile("s_waitcnt lgkmcnt(0)" ::: "memory"); SBAR();
#define PK(Lo, Hi) (bf16x8){Lo[0], Lo[1], Lo[2], Lo[3], Hi[0], Hi[1], Hi[2], Hi[3]}
  od = __builtin_amdgcn_mfma_f32_32x32x16_bf16(pa0, PK(l0, h0), od, 0, 0, 0);
  od = __builtin_amdgcn_mfma_f32_32x32x16_bf16(pa1, PK(l1, h1), od, 0, 0, 0);
  od = __builtin_amdgcn_mfma_f32_32x32x16_bf16(pa2, PK(l2, h2), od, 0, 0, 0);
  od = __builtin_amdgcn_mfma_f32_32x32x16_bf16(pa3, PK(l3, h3), od, 0, 0, 0);
#undef PK
}
__device__ __forceinline__ void pv_d0(f32x16* o, int vb, bf16x8 pa0, bf16x8 pa1, bf16x8 pa2, bf16x8 pa3) {
  pv_one<0>(o[0], vb, pa0, pa1, pa2, pa3); pv_one<1>(o[1], vb, pa0, pa1, pa2, pa3); pv_one<2>(o[2], vb, pa0, pa1, pa2, pa3); pv_one<3>(o[3], vb, pa0, pa1, pa2, pa3);
}

template <int DQK, bool MASKED, bool FIXM, int OUT>
__device__ __forceinline__ bool attn_unit(const bf16_t* __restrict__ Qb, const bf16_t* __restrict__ Kh, const bf16_t* __restrict__ Vh, bf16_t* __restrict__ Ob, const unsigned* __restrict__ mask, int ldq, int ldk, int q0, char* lds, float kmax2, const int w0, float lam = 0.f, float post = 0.f, const float* __restrict__ gain = nullptr) {
  constexpr int SHM_K = KVBLK * DQK * 2, ND0 = DQK / 16, NLD = DQK == 128 ? 4 : 3;
  int tid_ = tid_of(w0); asm volatile("" : "+v"(tid_));
  const int tid = tid_, wid = tid >> 6, lane = tid & 63, r32 = lane & 31, hi = lane >> 5;
  char* V_lds = lds; char* K_lds = lds + 3 * SHM_V;
  float* ws = (float*)(lds + 3 * SHM_V + 3 * SHM_K) + wid * 64; float* li_l = ws; float* al_l = ws + 32;
  float m_reg = -1e30f, l_reg = 0; f32x16 o[4] = {}; bf16x8 qr[ND0];
  const bf16_t* Qw = Qb + (long)(q0 + wid * QBLK + r32) * ldq + hi * 8;
  const unsigned* mrow = mask + (q0 + wid * QBLK + r32);
#pragma unroll
  for (int d0 = 0; d0 < ND0; ++d0) qr[d0] = *reinterpret_cast<const bf16x8*>(Qw + d0 * 16);
  float negb = 0.f;
  unsigned* badw = (unsigned*)(lds + 3 * SHM_V + 3 * SHM_K + NW * 256);
  if (FIXM) {
    if constexpr (!MASKED) {
      float qn2 = 0.f;
#pragma unroll
      for (int d0 = 0; d0 < ND0; ++d0)
#pragma unroll
        for (int e2 = 0; e2 < 8; ++e2) { const float v = bf2f((unsigned short)qr[d0][e2]); qn2 = __builtin_fmaf(v, v, qn2); }
      { auto rr = __builtin_amdgcn_permlane32_swap(__float_as_uint(qn2), __float_as_uint(qn2), false, false); qn2 = __uint_as_float(rr[0]) + __uint_as_float(rr[1]); }
      negb = -(sqrtf(qn2 * kmax2 * (DQK == 64 ? 2.0f : 4.0f)) * 1.02f + 1.0e-3f);
    }
    if (tid == 0) *badw = 0u;
  }
  const int sr = tid >> 4, sc = (tid & 15) * 8, vst0 = v_st(sr, sc), vst1 = v_st(32 + sr, sc);
  const int kr = DQK == 128 ? sr : (tid >> 3), kc = DQK == 128 ? sc : (tid & 7) * 8, kst = KSWZ(kr, kc * 2), kst1 = KSWZ(32 + kr, kc * 2);
  const int vb0 = (int)(uintptr_t)V_lds + v_rd_base(lane);
  struct { bf16x8 vs0, vs1, ks0, ks1; } sr_[2];
#define SLOAD(i, k0) do { sr_[i].vs0 = *reinterpret_cast<const bf16x8*>(&Vh[(long)((k0) + sr) * ldk + sc]); sr_[i].vs1 = *reinterpret_cast<const bf16x8*>(&Vh[(long)((k0) + 32 + sr) * ldk + sc]); \
    sr_[i].ks0 = *reinterpret_cast<const bf16x8*>(&Kh[(long)((k0) + kr) * ldk + kc]); if (DQK == 128) sr_[i].ks1 = *reinterpret_cast<const bf16x8*>(&Kh[(long)((k0) + 32 + kr) * ldk + kc]); } while (0)
#define SWRITE(s, i) do { *(bf16x8*)(V_lds + (s) * SHM_V + vst0) = sr_[i].vs0; *(bf16x8*)(V_lds + (s) * SHM_V + vst1) = sr_[i].vs1; \
    *(bf16x8*)(K_lds + (s) * SHM_K + kst) = sr_[i].ks0; if (DQK == 128) *(bf16x8*)(K_lds + (s) * SHM_K + kst1) = sr_[i].ks1; } while (0)
#define SWAIT() do { if (NLD == 4) asm volatile("s_waitcnt vmcnt(4)" ::: "memory"); else asm volatile("s_waitcnt vmcnt(3)" ::: "memory"); } while (0)
#define RESC(a) do { if (!FIXM && __any((a) < 1.f)) { if (hi == 0) al_l[r32] = (a); asm volatile("s_waitcnt lgkmcnt(0)" ::: "memory"); \
    _Pragma("unroll") for (int d = 0; d < 4; ++d) _Pragma("unroll") for (int r = 0; r < 16; ++r) o[d][r] *= al_l[crow(r, hi)]; } } while (0)
#define ROT() do { s_prev = s_cur; s_cur = s_next; s_next = (s_next == 2) ? 0 : s_next + 1; } while (0)
#define PSM(REL, P0, P1, MN, AL) do { if (FIXM) { AL = 1.f; _Pragma("unroll") for (int r_ = 0; r_ < 16; ++r_) P0[r_] = __builtin_amdgcn_exp2f(P0[r_]); } else partialSM<REL>(P0, P1, m_reg, MN, AL); } while (0)
  f32x16 pA0, pA1, pB0, pB1; float mnA, mnB, alA, alB; bf16x8 pa0, pa1, pa2, pa3;
  const int NT = (q0 >> 6) + 4, NTw = (q0 >> 6) + (w0 >> 1) + 1;
  if (w0 >= 4) __builtin_amdgcn_s_setprio(1);
  constexpr bool DMA = ((DQK == 64) && !MASKED && FIXM) || ((DQK == 128) && MASKED);
#define MW(t, a, b) do { if (MASKED) { a = mrow[(size_t)(2 * (t)) * L]; b = mrow[(size_t)(2 * (t) + 1) * L]; } } while (0)
  unsigned mw0 = 0u, mw1 = 0u;
  if constexpr (DMA) {
#define KOFF_(T_) (DQK == 64 ? (unsigned)((((T_) >> 3)) * ldk + ((((T_) & 7) ^ ((((T_) >> 3) >> 1) & 7)) * 8)) : (unsigned)(((T_) >> 4) * ldk + ((((T_) & 15) ^ (((T_) >> 4) & 15)) * 8)))
#define VKEY_(P_) (((((P_) >> 5) >> 2) * 8 + (((P_) >> 2) & 7)))
#define VOFF_(P_) ((unsigned)((((VKEY_(P_)) & ~0xC) | (((VKEY_(P_)) & 4) << 1) | (((VKEY_(P_)) & 8) >> 1)) * ldk + (((P_) >> 5) & 3) * 32 + ((P_) & 3) * 8))
    LAS unsigned char* Kd = (LAS unsigned char*)K_lds + w0 * 1024; LAS unsigned char* Vd = (LAS unsigned char*)V_lds + w0 * 1024;
    const unsigned kol_ = KOFF_(tid), vol_ = VOFF_(tid);
#define DMA_K(t_, slot_) do { int td_ = tid; asm volatile("" : "+v"(td_)); const unsigned ko_ = kol_; \
      __builtin_amdgcn_global_load_lds((const unsigned*)(Kh + (size_t)((t_) * KVBLK) * ldk + ko_), (LAS unsigned*)(Kd + (slot_) * SHM_K), 16, 0, 0); \
      if (DQK == 128) __builtin_amdgcn_global_load_lds((const unsigned*)(Kh + (size_t)((t_) * KVBLK + 32) * ldk + ko_), (LAS unsigned*)(Kd + (slot_) * SHM_K + 8192), 16, 0, 0); } while (0)
#define DMA_V(t_, slot_) do { int td_ = tid; asm volatile("" : "+v"(td_)); const unsigned vo_ = vol_;     \
                              __builtin_amdgcn_global_load_lds((const unsigned*)(Vh + (size_t)((t_) * KVBLK) * ldk + vo_), (LAS unsigned*)(Vd + (slot_) * SHM_V), 16, 0, 0); \
                              __builtin_amdgcn_global_load_lds((const unsigned*)(Vh + (size_t)((t_) * KVBLK + 32) * ldk + vo_), (LAS unsigned*)(Vd + (slot_) * SHM_V + 8192), 16, 0, 0); } while (0)
#define DBAR(n_) do { asm volatile("s_waitcnt vmcnt(" #n_ ") lgkmcnt(0)" ::: "memory"); __builtin_amdgcn_s_barrier(); asm volatile("" ::: "memory"); } while (0)
#define DBARS() do { if (DQK == 128) DBAR(4); else DBAR(3); } while (0)
    DMA_K(0, 0); DMA_V(0, 0); DMA_K(1, 1);
    DBAR(0);
    MW(0, mw0, mw1); qkt<DQK, MASKED, FIXM>(pA0, pA1, K_lds, qr, r32, hi, true, mw0, mw1, negb); PSM(false, pA0, pA1, mnA, alA); SBAR();
    DMA_K(2, 2); DMA_V(1, 1); SBAR();
    DBARS();
    int sk = 1, sv = 0;
#define S3(x) ((x) >= 3 ? (x) - 3 : (x))
#define DSTEP(PN0, PN1, PO0, PO1, MNN, ALN, ALO, T) do { \
      if ((T) < NTw) { MW(T, mw0, mw1); qkt<DQK, MASKED, FIXM>(PN0, PN1, K_lds + sk * SHM_K, qr, r32, hi, true, mw0, mw1, negb); } \
      if ((T) - 1 < NTw) finishSM(PO0, PO1, ALO, l_reg, pa0, pa1, pa2, pa3); SBAR(); \
      DMA_K(min((T) + 2, NT - 1), S3(sk + 2)); DMA_V((T) + 1, S3(sv + 2)); SBAR(); \
      if ((T) - 1 < NTw) pv_d0(o, vb0 + sv * SHM_V, pa0, pa1, pa2, pa3); if ((T) < NTw) PSM(!MASKED, PN0, PN1, MNN, ALN); else ALN = 1.f; \
      RESC(ALN); DBARS(); sk = S3(sk + 1); sv = S3(sv + 1); } while (0)
    for (int j = 1; j + 1 < NT; j += 2) {
      DSTEP(pB0, pB1, pA0, pA1, mnB, alB, alA, j);
      DSTEP(pA0, pA1, pB0, pB1, mnA, alA, alB, j + 1);
    }
#undef DSTEP
    MW(NT - 1, mw0, mw1); qkt<DQK, MASKED, FIXM>(pB0, pB1, K_lds + sk * SHM_K, qr, r32, hi, NT - 1 < NTw, mw0, mw1, negb); if (NT - 2 < NTw) finishSM(pA0, pA1, alA, l_reg, pa0, pa1, pa2, pa3); SBAR();
    if (NT - 2 < NTw) pv_d0(o, vb0 + sv * SHM_V, pa0, pa1, pa2, pa3); PSM(!MASKED, pB0, pB1, mnB, alB);
    RESC(alB);
    DBAR(0);
    finishSM(pB0, pB1, alB, l_reg, pa0, pa1, pa2, pa3); SBAR();
    if (NT - 1 < NTw) pv_d0(o, vb0 + S3(sv + 1) * SHM_V, pa0, pa1, pa2, pa3);
#undef S3
#undef KOFF_
#undef VKEY_
#undef VOFF_
#undef DMA_K
#undef DMA_V
#undef DBAR
#undef DBARS
  } else {
  constexpr int SE = 0, SO = 1;
  int s_prev = 0, s_cur = 0, s_next = 1;
  SLOAD(SE, 0); asm volatile("s_waitcnt vmcnt(0)" ::: "memory"); SWRITE(0, SE); __syncthreads();
  MW(0, mw0, mw1);
  qkt<DQK, MASKED, FIXM>(pA0, pA1, K_lds, qr, r32, hi, true, mw0, mw1, negb); PSM(false, pA0, pA1, mnA, alA);
  SLOAD(SO, KVBLK); SLOAD(SE, 2 * KVBLK);
  SWAIT(); SWRITE(1, SO); __syncthreads();
  ROT();
  for (int j = 1; j + 1 < NT; j += 2) {
    MW(j, mw0, mw1); SBAR(); qkt<DQK, MASKED, FIXM>(pB0, pB1, K_lds + s_cur * SHM_K, qr, r32, hi, j < NTw, mw0, mw1, negb);
    finishSM(pA0, pA1, alA, l_reg, pa0, pa1, pa2, pa3); SBAR();
    SLOAD(SO, (j + 2) * KVBLK); SBAR();
    if (j - 1 < NTw) pv_d0(o, vb0 + s_prev * SHM_V, pa0, pa1, pa2, pa3); PSM(!MASKED, pB0, pB1, mnB, alB);
    SWAIT(); SWRITE(s_next, SE);
    RESC(alB); __syncthreads(); ROT();
    MW(j + 1, mw0, mw1); SBAR(); qkt<DQK, MASKED, FIXM>(pA0, pA1, K_lds + s_cur * SHM_K, qr, r32, hi, j + 1 < NTw, mw0, mw1, negb);
    finishSM(pB0, pB1, alB, l_reg, pa0, pa1, pa2, pa3); SBAR();
    if (j + 3 < NT) SLOAD(SE, (j + 3) * KVBLK); SBAR();
    if (j < NTw) pv_d0(o, vb0 + s_prev * SHM_V, pa0, pa1, pa2, pa3); PSM(!MASKED, pA0, pA1, mnA, alA);
    SWAIT(); SWRITE(s_next, SO);
    RESC(alA); __syncthreads(); ROT();
  }
  MW(NT - 1, mw0, mw1); SBAR(); qkt<DQK, MASKED, FIXM>(pB0, pB1, K_lds + s_cur * SHM_K, qr, r32, hi, NT - 1 < NTw, mw0, mw1, negb);
  finishSM(pA0, pA1, alA, l_reg, pa0, pa1, pa2, pa3); SBAR();
  if (NT - 2 < NTw) pv_d0(o, vb0 + s_prev * SHM_V, pa0, pa1, pa2, pa3); PSM(!MASKED, pB0, pB1, mnB, alB);
  RESC(alB);
  finishSM(pB0, pB1, alB, l_reg, pa0, pa1, pa2, pa3); SBAR();
  if (NT - 1 < NTw) pv_d0(o, vb0 + s_cur * SHM_V, pa0, pa1, pa2, pa3);
  }
  if (hi == 0) li_l[r32] = l_reg; asm volatile("s_waitcnt lgkmcnt(0)" ::: "memory");
  float rli[16];
#pragma unroll
  for (int r = 0; r < 16; ++r) rli[r] = __builtin_amdgcn_rcpf(li_l[crow(r, hi)]);
  bf16_t* Ow = Ob + (long)(q0 + wid * QBLK) * LDO;
  unsigned* stash = (unsigned*)(lds + STASH_OFF);
#define OUT_TILE(EXPR) do { __syncthreads(); bf16_t* ot_ = (bf16_t*)(lds + wid * 8192); \
    _Pragma("unroll") for (int r = 0; r < 16; ++r) { const int orow = crow(r, hi); \
      _Pragma("unroll") for (int d0 = 0; d0 < 4; ++d0) ot_[orow * 128 + d0 * 32 + r32] = (bf16_t)(cvt_pk_bf16((EXPR), 0.f) & 0xffffu); } \
    asm volatile("s_waitcnt lgkmcnt(0)" ::: "memory"); \
    _Pragma("unroll") for (int i = 0; i < 8; ++i) { const int row_ = i * 4 + (lane >> 4), ch_ = lane & 15; \
      *(u32x4*)(Ow + (long)row_ * LDO + ch_ * 8) = *(const u32x4*)(ot_ + row_ * 128 + ch_ * 8); } } while (0)
  if (OUT == 0) {
    OUT_TILE(o[d0][r] * rli[r]);
  } else if (OUT == 1) {
#pragma unroll
    for (int d0 = 0; d0 < 4; ++d0)
#pragma unroll
      for (int rr = 0; rr < 8; ++rr) stash[(d0 * 8 + rr) * 512 + tid] = cvt_pk_bf16(o[d0][2 * rr] * rli[2 * rr], o[d0][2 * rr + 1] * rli[2 * rr + 1]);
  } else {
    float ss[16];
#pragma unroll
    for (int r = 0; r < 16; ++r) ss[r] = 0.f;
#pragma unroll
    for (int d0 = 0; d0 < 4; ++d0)
#pragma unroll
      for (int rr = 0; rr < 8; ++rr) { const unsigned w = stash[(d0 * 8 + rr) * 512 + tid];
        const float da = bflo(w) - lam * (o[d0][2 * rr] * rli[2 * rr]), db = bfhi(w) - lam * (o[d0][2 * rr + 1] * rli[2 * rr + 1]);
        o[d0][2 * rr] = da; o[d0][2 * rr + 1] = db; ss[2 * rr] = __builtin_fmaf(da, da, ss[2 * rr]); ss[2 * rr + 1] = __builtin_fmaf(db, db, ss[2 * rr + 1]); }
#pragma unroll
    for (int r = 0; r < 16; ++r) {
      {
#define SWZ_(m) ss[r] += __int_as_float(__builtin_amdgcn_ds_swizzle(__float_as_int(ss[r]), ((m) << 10) | 0x1f))
        SWZ_(1); SWZ_(2); SWZ_(4); SWZ_(8); SWZ_(16);
#undef SWZ_
      }
      ss[r] = post * __builtin_amdgcn_rsqf(ss[r] * (1.0f / 128.0f) + EPS); }
    float gn[4];
#pragma unroll
    for (int d0 = 0; d0 < 4; ++d0) gn[d0] = gain[d0 * 32 + r32];
    OUT_TILE(o[d0][r] * ss[r] * gn[d0]);
  }
#undef OUT_TILE
  if (FIXM && __any(!(l_reg > 7.0e-31f) || !(l_reg < 1.0e30f))) { if (lane == 0) *badw = 1u; }
  if (w0 >= 4) __builtin_amdgcn_s_setprio(0);
  __syncthreads();
  bool bad = false; if (FIXM) { bad = *badw != 0u; __syncthreads(); }
#undef PSM
#undef MW
#undef ROT
#undef SLOAD
#undef SWRITE
#undef SWAIT
#undef RESC
  return bad;
}
#undef SBAR
}

namespace dsa {
__device__ __forceinline__ unsigned mono(float s) { const unsigned b = __float_as_uint(s); return b ^ ((unsigned)((int)b >> 31) | 0x80000000u); }
__device__ __forceinline__ float relu_i(float s) { const int b = __float_as_int(s); return __int_as_float(b > 0 ? b : 0); }
__device__ __forceinline__ float fmac1(float a, float b, float acc) { asm("v_fmac_f32_e32 %0, %1, %2" : "+v"(acc) : "v"(a), "v"(b)); return acc; }
__device__ __forceinline__ void load_group(bf16x8 (&k)[4], const bf16_t* __restrict__ KI, int key0, int qi, int g) {
  const bf16_t* kp = KI + (size_t)(key0 + qi) * 64 + g * 8;
  k[0] = *reinterpret_cast<const bf16x8*>(kp); k[1] = *reinterpret_cast<const bf16x8*>(kp + 32);
  k[2] = *reinterpret_cast<const bf16x8*>(kp + 16 * 64); k[3] = *reinterpret_cast<const bf16x8*>(kp + 16 * 64 + 32);
}
__device__ __forceinline__ void score_group(f32x4& ta, f32x4& tb, const bf16x8 (&k)[4], const bf16x8 (&qf)[8][2], const float (&wq)[8]) {
  ta = (f32x4){0.f, 0.f, 0.f, 0.f}; tb = (f32x4){0.f, 0.f, 0.f, 0.f};
#pragma unroll
  for (int h = 0; h < 8; ++h) {
    f32x4 sa = (f32x4){0.f, 0.f, 0.f, 0.f}, sb = (f32x4){0.f, 0.f, 0.f, 0.f};
    sa = __builtin_amdgcn_mfma_f32_16x16x32_bf16(k[0], qf[h][0], sa, 0, 0, 0); sb = __builtin_amdgcn_mfma_f32_16x16x32_bf16(k[2], qf[h][0], sb, 0, 0, 0);
    sa = __builtin_amdgcn_mfma_f32_16x16x32_bf16(k[1], qf[h][1], sa, 0, 0, 0); sb = __builtin_amdgcn_mfma_f32_16x16x32_bf16(k[3], qf[h][1], sb, 0, 0, 0);
#pragma unroll
    for (int r = 0; r < 4; ++r) { ta[r] = fmac1(wq[h], relu_i(sa[r]), ta[r]); tb[r] = fmac1(wq[h], relu_i(sb[r]), tb[r]); }
  }
}
template <bool RAW>
__device__ __forceinline__ unsigned hist_find(const LAS unsigned* hq, unsigned need, unsigned& above, int lane) {
  unsigned wv[16]; unsigned ls = 0u;
  if (RAW) {
    const bool ng = lane >= 32; unsigned rv[16];
#pragma unroll
    for (int i = 0; i < 4; ++i) { const u32x4 v = *(const LAS u32x4*)(hq + (ng ? 16 * lane : 512 - 16 * (lane + 1)) + 4 * i); rv[4 * i] = v.x; rv[4 * i + 1] = v.y; rv[4 * i + 2] = v.z; rv[4 * i + 3] = v.w; }
#pragma unroll
    for (int i = 0; i < 16; ++i) { const unsigned x = rv[15 - i]; wv[i] = ng ? ((x >> 16) | (x << 16)) : rv[i]; }
  } else {
#pragma unroll
  for (int i = 0; i < 4; ++i) { const u32x4 v = *(const LAS u32x4*)(hq + 1024 - 16 * (lane + 1) + 4 * i); wv[4 * i] = v.x; wv[4 * i + 1] = v.y; wv[4 * i + 2] = v.z; wv[4 * i + 3] = v.w; }
  }
#pragma unroll
  for (int i = 0; i < 16; ++i) ls += (wv[i] & 0xffffu) + (wv[i] >> 16);
  unsigned inc = ls;
#define DPPADD_(ctrl_, rmask_) inc += (unsigned)__builtin_amdgcn_update_dpp(0, (int)inc, ctrl_, rmask_, 0xf, false)
  DPPADD_(0x111, 0xf); DPPADD_(0x112, 0xf); DPPADD_(0x114, 0xf); DPPADD_(0x118, 0xf); DPPADD_(0x142, 0xa); DPPADD_(0x143, 0xc);
#undef DPPADD_
  const unsigned long long bal = __ballot(inc >= need);
  const int ls_ = bal ? (__ffsll((long long)bal) - 1) : 63;
  const int lsu_ = __builtin_amdgcn_readfirstlane(ls_);
  unsigned cum = (unsigned)__builtin_amdgcn_readlane((int)(inc - ls), lsu_);
  unsigned bin = 0u, ab = 0u; bool found = false;
#pragma unroll
  for (int i = 15; i >= 0; --i) {
    const unsigned chi = wv[i] >> 16, clo = wv[i] & 0xffffu;
    if (!found && cum + chi >= need) { found = true; bin = 2 * i + 1; ab = cum; } cum += found ? 0u : chi;
    if (!found && cum + clo >= need) { found = true; bin = 2 * i; ab = cum; } cum += found ? 0u : clo;
  }
  bin += (unsigned)(1024 - 16 * (lane + 1)) * 2u;
  above = (unsigned)__builtin_amdgcn_readlane((int)ab, lsu_);
  return (unsigned)__builtin_amdgcn_readlane((int)bin, lsu_);
}
constexpr int CAND_CAP = 1024;
__device__ __forceinline__ void select_block(int q0, const bf16_t* __restrict__ QI, const bf16_t* __restrict__ KI, const float* __restrict__ WI, unsigned* __restrict__ MASK, LAS unsigned char* lds, const int w0) {
  int tid_ = tid_of(w0); asm volatile("" : "+v"(tid_));
  const int tid = tid_, lane = tid & 63, wave = __builtin_amdgcn_readfirstlane(tid >> 6), qi = lane & 15, g = lane >> 4;
  const int n = ((q0 >> 6) + 1) << 6, NT = n >> 5;
  LAS unsigned* hist = (LAS unsigned*)lds;
  LAS unsigned* cand = (LAS unsigned*)(lds + 65536);
  LAS unsigned* tb = (LAS unsigned*)(lds + 131072);
  if (n <= 256) {
    for (int t = wave; t < NT; t += 8) if (g == 0) MASK[(size_t)t * L + q0 + qi] = 0xffffffffu;
    return;
  }
  bf16x8 qf[8][2]; float wq[8];
  { const bf16_t* qp = QI + (size_t)(q0 + qi) * 512 + g * 8;
#pragma unroll
    for (int h = 0; h < 8; ++h) { qf[h][0] = *reinterpret_cast<const bf16x8*>(qp + h * 64); qf[h][1] = *reinterpret_cast<const bf16x8*>(qp + h * 64 + 32); wq[h] = WI[(size_t)(q0 + qi) * 8 + h]; } }
  f32x4 ta, tb4; bf16x8 kc[4], kn[4];
  LAS unsigned char* hq = (LAS unsigned char*)(hist + qi * 1024);
  unsigned* mq = MASK + q0 + qi;
  __syncthreads();
#pragma unroll
  for (int i = 0; i < 8; ++i) *(LAS u32x4*)(hist + (size_t)(i * 512 + tid) * 4) = (u32x4){0u, 0u, 0u, 0u};
  if (tid < 17) tb[48 + tid] = 0u;
  __syncthreads();
#define HISTA() do { _Pragma("unroll") for (int r = 0; r < 8; ++r) {     \
      const unsigned b = __float_as_uint(r < 4 ? ta[r & 3] : tb4[r & 3]); unsigned wd, inc; \
      asm("v_lshrrev_b32 %0, 22, %1" : "=v"(wd) : "v"(b)); \
      asm("v_mad_u32_u24 %0, %1, %2, 1" : "=v"(inc) : "v"((b >> 21) & 1u), "s"(0xffffu)); \
      __hip_atomic_fetch_add((LAS unsigned*)(hq + (wd << 2)), inc, __ATOMIC_RELAXED, __HIP_MEMORY_SCOPE_WORKGROUP); } } while (0)
  load_group(kc, KI, wave * 32, qi, g);
#pragma unroll 1
  for (int t = wave; t < NT; t += 16) {
    load_group(kn, KI, min(t + 8, NT - 1) * 32, qi, g);
    score_group(ta, tb4, kc, qf, wq);
    HISTA();
    load_group(kc, KI, min(t + 16, NT - 1) * 32, qi, g);
    if (t + 8 < NT) { score_group(ta, tb4, kn, qf, wq); HISTA(); }
  }
#undef HISTA
  __syncthreads();
#pragma unroll 1
  for (int qq = 0; qq < 2; ++qq) {
    const int q = wave * 2 + qq; unsigned above;
    const unsigned bin = hist_find<true>(hist + q * 1024, 256u, above, lane);
    if (lane == 0) { tb[q] = bin; tb[16 + q] = 256u - above; }
  }
  __syncthreads();
#pragma unroll
  for (int i = 0; i < 8; ++i) *(LAS u32x4*)(hist + (size_t)(i * 512 + tid) * 4) = (u32x4){0u, 0u, 0u, 0u};
  __syncthreads();
  const unsigned bs = tb[qi];
  const float flo = __uint_as_float(bs >= 1024u ? (bs - 1024u) << 21 : ((2047u - bs) << 21) | 0x1fffffu);
  const float fhi = bs >= 2043u ? INFINITY : __uint_as_float(bs + 1u >= 1024u ? (bs + 1u - 1024u) << 21 : ((2046u - bs) << 21) | 0x1fffffu);
  LAS unsigned* cq = cand + qi * CAND_CAP;
#define CLASSB(T_) do { unsigned w = 0u; \
      _Pragma("unroll") for (int r = 0; r < 8; ++r) { \
        const float sc = r < 4 ? ta[r & 3] : tb4[r & 3]; const bool def = sc >= fhi; \
        const int pos = (r < 4 ? r : 12 + r) + 4 * g;                                    \
        w |= (def ? 1u : 0u) << (r < 4 ? r : 12 + r); \
        if (sc >= flo && !def) {                                                          \
          const unsigned key = mono(sc); \
          __hip_atomic_fetch_add((LAS unsigned*)(hq + ((key >> 9) & 0xffcu)), 1u << ((key >> 6) & 16u), __ATOMIC_RELAXED, __HIP_MEMORY_SCOPE_WORKGROUP); \
          const unsigned ix = __hip_atomic_fetch_add(tb + 48 + qi, 1u, __ATOMIC_RELAXED, __HIP_MEMORY_SCOPE_WORKGROUP); \
          if (ix < (unsigned)CAND_CAP) cq[ix] = ((unsigned)((T_) * 32 + pos) << 11) | ((key >> 10) & 2047u); else tb[64] = 1u; \
        } } \
      w <<= 4 * g; { auto s1_ = __builtin_amdgcn_permlane16_swap(w, w, false, false); w = s1_[0] | s1_[1]; auto s2_ = __builtin_amdgcn_permlane32_swap(w, w, false, false); w = s2_[0] | s2_[1]; }     \
      if (g == 0) mq[(size_t)(T_) * L] = w; } while (0)
  load_group(kc, KI, wave * 32, qi, g);
#pragma unroll 1
  for (int t = wave; t < NT; t += 16) {
    load_group(kn, KI, min(t + 8, NT - 1) * 32, qi, g);
    score_group(ta, tb4, kc, qf, wq);
    CLASSB(t);
    load_group(kc, KI, min(t + 16, NT - 1) * 32, qi, g);
    if (t + 8 < NT) { score_group(ta, tb4, kn, qf, wq); CLASSB(t + 8); }
  }
#undef CLASSB
  asm volatile("s_waitcnt vmcnt(0)" ::: "memory");
  __syncthreads();
#pragma unroll 1
  for (int qq = 0; qq < 2; ++qq) {
    const int q = wave * 2 + qq; unsigned above;
    const unsigned bin = hist_find<false>(hist + q * 1024, tb[16 + q], above, lane);
    if (lane == 0) tb[32 + q] = (tb[q] << 11) | bin;
  }
  __syncthreads();
  if (tb[64] == 0u) {
#pragma unroll 1
    for (int qq = 0; qq < 2; ++qq) {
      const int q = wave * 2 + qq; const unsigned b2 = tb[32 + q] & 2047u; const int cnt = (int)tb[48 + q];
      for (int i = lane; i < cnt; i += 64) { const unsigned c = cand[q * CAND_CAP + i];
        if ((c & 2047u) >= b2) { const unsigned kidx = c >> 11; atomicOr(MASK + (size_t)(kidx >> 5) * L + q0 + q, 1u << (kidx & 31u)); } }
    }
  } else {
    const unsigned T22 = tb[32 + qi];
    load_group(kc, KI, wave * 32, qi, g);
#pragma unroll 1
    for (int t = wave; t < NT; t += 8) {
      if (t + 8 < NT) load_group(kn, KI, (t + 8) * 32, qi, g);
      score_group(ta, tb4, kc, qf, wq);
#pragma unroll
      for (int i = 0; i < 4; ++i) kc[i] = kn[i];
      unsigned w = 0u;
#pragma unroll
      for (int r = 0; r < 4; ++r) { w |= ((mono(ta[r]) >> 10) >= T22 ? 1u : 0u) << r; w |= ((mono(tb4[r]) >> 10) >= T22 ? 1u : 0u) << (16 + r); }
      w <<= 4 * g; { auto s1_ = __builtin_amdgcn_permlane16_swap(w, w, false, false); w = s1_[0] | s1_[1]; auto s2_ = __builtin_amdgcn_permlane32_swap(w, w, false, false); w = s2_[0] | s2_[1]; }
      if (g == 0) mq[(size_t)t * L] = w;
    }
  }
  __syncthreads();
}
}

constexpr size_t MiB = 1u << 20;
constexpr size_t WS_CTL = 0, WS_SSQ = 1 * MiB, ZERO_BYTES = 2 * MiB;
constexpr size_t WS_MISC = 2 * MiB;
constexpr size_t WS_ROPE128 = 3 * MiB, WS_ROPE64 = 11 * MiB;
constexpr size_t WS_LBP = 15 * MiB, WS_BBT = 16 * MiB + 512 * 1024;
constexpr size_t WS_S5MF = 18 * MiB, WS_S5E = 42 * MiB;
constexpr size_t WS_KMEM = 58 * MiB, WS_VMEMT = 62 * MiB, WS_MEMB = 66 * MiB, WS_WGLU = 67 * MiB;
constexpr size_t WS_WIN = 70 * MiB, WS_WOUT = 162 * MiB, WS_WQ = 194 * MiB, WS_WK = 226 * MiB, WS_WV = 258 * MiB, WS_WO = 290 * MiB, WS_WFF1 = 322 * MiB, WS_WFF2 = 450 * MiB;
constexpr size_t WS_XSA = WS_WK, WS_XOB = WS_WV;
constexpr size_t WS_XB = 578 * MiB;
constexpr size_t WS_ACT = 642 * MiB;
constexpr size_t WS_QA = WS_ACT, WS_KA = WS_ACT + 16 * MiB, WS_VA = WS_ACT + 32 * MiB, WS_QI = WS_ACT + 48 * MiB, WS_KI = WS_ACT + 64 * MiB, WS_WI = WS_ACT + 66 * MiB;
constexpr size_t WS_S5A = WS_ACT + 67 * MiB, WS_S5EO = WS_ACT + 91 * MiB, WS_YB = WS_ACT + 107 * MiB;
constexpr size_t WS_QC = WS_ACT + 123 * MiB, WS_KC = WS_ACT + 155 * MiB, WS_VC = WS_ACT + 187 * MiB, WS_OD = WS_ACT + 219 * MiB, WS_CAT = WS_ACT + 283 * MiB;
constexpr size_t WS_QX = WS_ACT, WS_PX = WS_ACT + 64 * MiB, WS_OX = WS_ACT + 96 * MiB;
constexpr size_t WS_HID = WS_ACT;
constexpr size_t WS_SSQP = WS_ACT + 347 * MiB;
constexpr size_t WS_MASK = WS_SSQP + 26 * MiB;
constexpr size_t WS_END = WS_MASK + 32 * MiB;
static_assert(WS_HID + (size_t)L * DFF * 2 <= WS_SSQP && WS_CAT + (size_t)L * DM * 2 <= WS_SSQP && WS_OX + (size_t)L * DM * 2 <= WS_CAT, "d_ws map");
constexpr int CW_BAR = 4096, CW_Q = 8192, CW_KMAX = 12288;

constexpr int RING_BYTES = 131072, EPI_OFF = 131072, LDS_BYTES = 147456, LDSCTL_OFF = LDS_BYTES - 1024, MISC_OFF = LDSCTL_OFF + 320;

typedef GAS unsigned gu32;
#define RLX_AGENT __ATOMIC_RELAXED, __HIP_MEMORY_SCOPE_AGENT
#define LDS_WAIT() asm volatile("s_waitcnt lgkmcnt(0)" ::: "memory")
#define VM_WAIT() asm volatile("s_waitcnt vmcnt(0)" ::: "memory")
#define XB_TMO      128
#define XB_XCNT(j)  (256  + 64 * (j))
#define XB_XSUB(j)  (1280 + 64 * (j))
#define XB_XGEN(j)  (2304 + 64 * (j))
#define XB_TOP      3328
#define XB_TOPGEN   3392
#define XCD_BAR_WORDS 3456
#define XB_SPIN_CAP (1u << 23)
__device__ __forceinline__ unsigned xb_ld(unsigned* p)              { return __hip_atomic_load(p, __ATOMIC_RELAXED, __HIP_MEMORY_SCOPE_AGENT); }
__device__ __forceinline__ unsigned xb_add(unsigned* p, unsigned v) { return __hip_atomic_fetch_add(p, v, __ATOMIC_RELAXED, __HIP_MEMORY_SCOPE_AGENT); }
__device__ __forceinline__ unsigned xb_xcc_id() { return (unsigned)__builtin_amdgcn_s_getreg((3 << 11) | 20) & 0xFu; }
#define XB_SPIN(cond, bar) do { unsigned _sp = 0; while (cond) { __builtin_amdgcn_s_sleep(1); \
    if ((++_sp & 255u) == 0u) { if (xb_ld(&(bar)[XB_TMO])) break; if (_sp > XB_SPIN_CAP) { atomicAdd(&(bar)[XB_TMO], 1u); break; } } } } while (0)
struct XcdBarrier { unsigned* bar; unsigned x; volatile LAS unsigned* st; };
__device__ __forceinline__ XcdBarrier xcd_barrier_post(unsigned* bar, volatile LAS unsigned* st) {
    XcdBarrier b; b.bar = bar; b.x = xb_xcc_id(); b.st = st;
    if (threadIdx.x == 0) (void)xb_add(&bar[XB_XCNT(b.x)], 1u);
    return b;
}
__device__ __forceinline__ void xcd_barrier_complete(unsigned* bar, unsigned x, unsigned& nloc, unsigned& nx) {
    const unsigned G = gridDim.x * gridDim.y * gridDim.z;
    unsigned sum, cnt, mine, sp = 0u;
    for (;;) {
        sum = 0u; cnt = 0u; mine = 0u;
#pragma unroll
        for (unsigned j = 0; j < 16; ++j) { const unsigned c = xb_ld(&bar[XB_XCNT(j)]); sum += c; cnt += (c > 0u) ? 1u : 0u; mine = (j == x) ? c : mine; }
        if (sum == G) break;
        __builtin_amdgcn_s_sleep(1);
        if ((++sp & 255u) == 0u) { if (xb_ld(&bar[XB_TMO])) break; if (sp > XB_SPIN_CAP) { atomicAdd(&bar[XB_TMO], 1u); break; } }
    }
    nloc = mine > 0u ? mine : 1u; nx = cnt > 0u ? cnt : 1u;
}
__device__ __forceinline__ void xcd_barrier(const XcdBarrier& b, const int w0) {
    asm volatile("s_waitcnt vmcnt(0)" ::: "memory");
    __syncthreads();
    int t0_ = tid_of(w0); asm volatile("" : "+v"(t0_));
    if (t0_ == 0) {
        unsigned* bar = b.bar;
        __builtin_amdgcn_s_waitcnt(0);
        unsigned nloc = b.st[0], nx = b.st[1];
        if (nloc == 0u) { xcd_barrier_complete(bar, b.x, nloc, nx); b.st[0] = nloc; b.st[1] = nx; }
        const unsigned old = xb_add(&bar[XB_XSUB(b.x)], 1u);
        const unsigned gen = old / nloc;
        if (old + 1u == (gen + 1u) * nloc) {
            __builtin_amdgcn_fence(__ATOMIC_RELEASE, "agent");
            asm volatile("s_waitcnt vmcnt(0)" ::: "memory");
            const unsigned og = xb_add(&bar[XB_TOP], 1u);
            const unsigned tg = og / nx;
            if (og + 1u == (tg + 1u) * nx) xb_add(&bar[XB_TOPGEN], 1u);
            else XB_SPIN(xb_ld(&bar[XB_TOPGEN]) == tg, bar);
            __builtin_amdgcn_fence(__ATOMIC_ACQUIRE, "agent");
            xb_add(&bar[XB_XGEN(b.x)], 1u);
            asm volatile("s_waitcnt vmcnt(0)" ::: "memory");
        } else {
            XB_SPIN(xb_ld(&bar[XB_XGEN(b.x)]) == gen, bar);
            __builtin_amdgcn_fence(__ATOMIC_ACQUIRE, "agent");
            asm volatile("s_waitcnt vmcnt(0)" ::: "memory");
        }
    }
    __syncthreads();
}

__device__ __forceinline__ float wave_sum(float v) {
#pragma unroll
    for (int o = 1; o < 64; o <<= 1) v += __shfl_xor(v, o);
    return v;
}
__device__ __forceinline__ float wave_max(float v) {
#pragma unroll
    for (int o = 1; o < 64; o <<= 1) v = fmaxf(v, __shfl_xor(v, o));
    return v;
}
__device__ __forceinline__ void cs_reduced(double a, float& c, float& s) {
    const double k = rint(a * 0.15915494309189535);
    const double r = (a - k * 6.283185307179586) - k * 2.4492935982947064e-16;
    const float rf = (float)r; c = cosf(rf); s = sinf(rf);
}

__device__ __forceinline__ int perm_pair(int d, int half) { return d < half ? 2 * d : 2 * (d - half) + 1; }
__device__ __forceinline__ void inproj_map(int n, int& row, float& cs) {
    cs = 1.0f;
    if (n < 512) { row = (n & ~127) + perm_pair(n & 127, 64); cs = SCL_A; }
    else if (n < 1024) { const int m = n - 512; row = 512 + (m & ~127) + perm_pair(m & 127, 64); }
    else if (n < 1536) { row = n; }
    else if (n < 2048) { const int m = n - 1536; row = 1536 + (m & ~63) + perm_pair(m & 63, 32); }
    else if (n < 2112) { row = 2048 + perm_pair(n - 2048, 32); }
    else if (n < 2120) { row = n; }
    else if (n < 2632) { row = 2304 + (n - 2120); }
    else if (n < 3656) { const int m = n - 2632; row = 2816 + (m & ~63) + perm_pair(m & 63, 32); cs = SCL_C; }
    else if (n < 4680) { const int m = n - 3656; row = 3840 + (m & ~63) + perm_pair(m & 63, 32); }
    else { row = 4864 + (n - 4680); }
}
__device__ __forceinline__ void transpose_item(const float* __restrict__ W, int K, int N, bf16_t* __restrict__ WT, const float* __restrict__ gain, int kind, LAS float* scr, int kb, int nb, int lane) {
    const int k0 = 64 * kb, n0 = 64 * nb;
    {
        const int c4 = (lane & 15) * 4, n = n0 + c4; f32x4 v[16];
#pragma unroll
        for (int i = 0; i < 16; ++i) { const int kk = 4 * i + (lane >> 4); v[i] = (n < N) ? *(const f32x4*)(W + (size_t)(k0 + kk) * N + n) : (f32x4){0.f, 0.f, 0.f, 0.f}; }
#pragma unroll
        for (int i = 0; i < 16; ++i) { const int kk = 4 * i + (lane >> 4); const float g = gain ? gain[k0 + kk] : 1.0f; LAS float* d = scr + kk * 65 + c4;
            d[0] = v[i][0] * g; d[1] = v[i][1] * g; d[2] = v[i][2] * g; d[3] = v[i][3] * g; }
    }
    LDS_WAIT(); asm volatile("" ::: "memory");
    const int c = lane & 7;
#pragma unroll
    for (int jj = 0; jj < 8; ++jj) {
        const int nn = (lane >> 3) + 8 * jj, n = n0 + nn;
        if (n < N) {
            int row = n; float cs = 1.0f;
            if (kind == 1) inproj_map(n, row, cs); else if (kind == 2) cs = SCL_X;
            const LAS float* s = scr + (8 * c) * 65 + nn;
            u32x4 o; o.x = cvt_pk_bf16(s[0 * 65] * cs, s[1 * 65] * cs); o.y = cvt_pk_bf16(s[2 * 65] * cs, s[3 * 65] * cs); o.z = cvt_pk_bf16(s[4 * 65] * cs, s[5 * 65] * cs); o.w = cvt_pk_bf16(s[6 * 65] * cs, s[7 * 65] * cs);
            *(u32x4*)(WT + (size_t)row * K + k0 + 8 * c) = o;
        }
    }
    LDS_WAIT(); asm volatile("" ::: "memory");
}

struct Args { const float* in[30]; float* out; unsigned char* ws; int ph_lo, ph_hi; };
constexpr int NWAVES = 8, NSTEP_PRO = 3, NSTEP_LAYER = 8, NSTEPS = NSTEP_PRO + DEPTH * NSTEP_LAYER + 1;

__global__ void __launch_bounds__(NWAVES * 64, 2) fwd_kernel(Args args) {
    extern __shared__ __attribute__((aligned(16))) unsigned char lds_raw[];
    LAS unsigned char* lds = (LAS unsigned char*)lds_raw;
    volatile LAS unsigned* MISC = (volatile LAS unsigned*)(lds + MISC_OFF);
    const int tid = threadIdx.x, lane = tid & 63, wave = __builtin_amdgcn_readfirstlane(tid >> 6);
    const int wave0 = wave;
#define W0() ({ int w_ = wave0; asm volatile("" : "+s"(w_)); w_; })
    const int G = gridDim.x; const int bx = blockIdx.x; const int vcu = (G % 8 == 0) ? (bx % 8) * (G / 8) + bx / 8 : bx;
    const int gw = vcu * NWAVES + wave, NGW = G * NWAVES;
    unsigned* ctl = (unsigned*)(args.ws + WS_CTL);
    for (int u = tid; u < (LDS_BYTES - LDSCTL_OFF) / 4; u += NWAVES * 64) ((LAS unsigned*)(lds + LDSCTL_OFF))[u] = 0u;
    __syncthreads();
    const int lo = args.ph_lo, hi = args.ph_hi;
    XcdBarrier bar; bar.bar = ctl + CW_BAR; bar.x = 0; bar.st = nullptr;
    if (hi - lo > 1) bar = xcd_barrier_post(ctl + CW_BAR, MISC + 8);
#ifndef SITE_MASK
#define SITE_MASK 0xFFFFu
#endif
#define SITE(id) (((SITE_MASK) >> (id)) & 1u)
#ifndef REP_MASK
#define REP_MASK 0u
#endif
#ifndef REP_N
#define REP_N 2
#endif
#define REPS(id) ((((REP_MASK) >> (id)) & 1u) ? (REP_N) : 1)
#define IN(k) (lo <= (k) && (k) < hi)
#define SEAM(k) do { if ((k) + 1 < hi) { XcdBarrier b_ = bar; asm volatile("" : "+s"(b_.bar)); xcd_barrier(b_, W0()); } } while (0)

    typedef __attribute__((address_space(4))) const Args CArgs;
    CArgs* const ap = (CArgs*)__builtin_amdgcn_kernarg_segment_ptr();
#define ENV() CArgs* ap_ = ap; asm volatile("" : "+s"(ap_)); unsigned char* const ws = ap_->ws; (void)ws
#define x_in (ap_->in[0])
#define mem (ap_->in[1])
#define norm_mix (ap_->in[2])
#define w_in (ap_->in[3])
#define s5_a_re (ap_->in[4])
#define s5_a_im (ap_->in[5])
#define s5_log_dt (ap_->in[6])
#define s5_b_re (ap_->in[7])
#define s5_b_im (ap_->in[8])
#define s5_c_re (ap_->in[9])
#define s5_c_im (ap_->in[10])
#define s5_d (ap_->in[11])
#define s5_w_glu (ap_->in[12])
#define s5_b_glu (ap_->in[13])
#define lam_q1 (ap_->in[14])
#define lam_k1 (ap_->in[15])
#define lam_q2 (ap_->in[16])
#define lam_k2 (ap_->in[17])
#define subln (ap_->in[18])
#define w_out (ap_->in[19])
#define norm_xattn (ap_->in[20])
#define norm_mem (ap_->in[21])
#define xq (ap_->in[22])
#define xk (ap_->in[23])
#define xv (ap_->in[24])
#define xo (ap_->in[25])
#define norm_mlp (ap_->in[26])
#define w_ff1 (ap_->in[27])
#define w_ff2 (ap_->in[28])
#define norm_final (ap_->in[29])
#define xres (ap_->out)
#define SSQ ((float*)(ws + WS_SSQP))
#define RSTDM ((float*)(ws + WS_MISC))
#define LAMT (RSTDM + 256)
#define GXT (RSTDM + 1024)
#define KMAX2 ((float*)(ws + WS_MISC + 32 * 1024))
#define KMAXP ((float*)(ws + WS_MISC + 64 * 1024))
#define ROPE128 ((float*)(ws + WS_ROPE128))
#define ROPE64 ((float*)(ws + WS_ROPE64))
#define LBP ((float*)(ws + WS_LBP))
#define BBT ((float*)(ws + WS_BBT))
#define S5MF ((bf16_t*)(ws + WS_S5MF))
#define S5EM ((bf16_t*)(ws + WS_S5E))
#define KMEM ((bf16_t*)(ws + WS_KMEM))
#define VMEMT ((bf16_t*)(ws + WS_VMEMT))
#define MEMB ((bf16_t*)(ws + WS_MEMB))
#define WGLU ((bf16_t*)(ws + WS_WGLU))
#define WIN ((bf16_t*)(ws + WS_WIN))
#define WOUT ((bf16_t*)(ws + WS_WOUT))
#define WQ ((bf16_t*)(ws + WS_WQ))
#define WK ((bf16_t*)(ws + WS_WK))
#define WV ((bf16_t*)(ws + WS_WV))
#define WO ((bf16_t*)(ws + WS_WO))
#define WFF1 ((bf16_t*)(ws + WS_WFF1))
#define WFF2 ((bf16_t*)(ws + WS_WFF2))
#define XB ((bf16_t*)(ws + WS_XB))
#define QA ((bf16_t*)(ws + WS_QA))
#define KA ((bf16_t*)(ws + WS_KA))
#define VA ((bf16_t*)(ws + WS_VA))
#define QI ((bf16_t*)(ws + WS_QI))
#define KI ((bf16_t*)(ws + WS_KI))
#define WI ((float*)(ws + WS_WI))
#define S5A ((bf16_t*)(ws + WS_S5A))
#define S5EO ((float*)(ws + WS_S5EO))
#define YB ((bf16_t*)(ws + WS_YB))
#define QC ((bf16_t*)(ws + WS_QC))
#define KC ((bf16_t*)(ws + WS_KC))
#define VC ((bf16_t*)(ws + WS_VC))
#define OD ((bf16_t*)(ws + WS_OD))
#define CAT ((bf16_t*)(ws + WS_CAT))
#define QX ((bf16_t*)(ws + WS_QX))
#define PX ((bf16_t*)(ws + WS_PX))
#define OX ((bf16_t*)(ws + WS_OX))
#define HID ((bf16_t*)(ws + WS_HID))
#define MASK ((unsigned*)(ws + WS_MASK))
#define XSA ((bf16_t*)(ws + WS_XSA))
#define XOB ((bf16_t*)(ws + WS_XOB))

    if (SITE(0) && IN(0)) {
        ENV();
            for (int rep = 0; rep < REPS(0); ++rep) {
            int tid_o = tid_of(W0()); asm volatile("" : "+v"(tid_o)); const int tid = tid_o, lane = tid & 63, wave = __builtin_amdgcn_readfirstlane(tid >> 6), gw = vcu * NWAVES + wave; (void)lane; (void)gw;
        LAS float* scr = (LAS float*)(lds + wave * 16640);
        constexpr int I_IN = 32 * 90, I_SQ = 32 * 32, I_F1 = 32 * 128, I_F2 = 128 * 32, I_GL = 8 * 8, PER_L = I_IN + 4 * I_SQ + I_F1 + I_F2 + I_GL;
        for (int it = gw; it < DEPTH * PER_L; it += NGW) {
            const int l = it / PER_L; int r = it % PER_L;
            if (r < I_IN) { transpose_item(w_in + (size_t)l * DM * NIN, DM, NIN, WIN + (size_t)l * NINP * DM, norm_mix + l * DM, 1, scr, r / 90, r % 90, lane); continue; } r -= I_IN;
            if (r < I_SQ) { transpose_item(w_out + (size_t)l * DM * DM, DM, DM, WOUT + (size_t)l * DM * DM, nullptr, 0, scr, r / 32, r % 32, lane); continue; } r -= I_SQ;
            if (r < I_SQ) { transpose_item(xk + (size_t)l * DM * DM, DM, DM, WK + (size_t)l * DM * DM, norm_mem + l * DM, 0, scr, r / 32, r % 32, lane); continue; } r -= I_SQ;
            if (r < I_SQ) { transpose_item(xv + (size_t)l * DM * DM, DM, DM, WV + (size_t)l * DM * DM, norm_mem + l * DM, 0, scr, r / 32, r % 32, lane); continue; } r -= I_SQ;
            if (r < I_SQ) { transpose_item(xo + (size_t)l * DM * DM, DM, DM, WO + (size_t)l * DM * DM, nullptr, 0, scr, r / 32, r % 32, lane); continue; } r -= I_SQ;
            if (r < I_F1) { transpose_item(w_ff1 + (size_t)l * DM * DFF, DM, DFF, WFF1 + (size_t)l * DFF * DM, norm_mlp + l * DM, 0, scr, r / 128, r % 128, lane); continue; } r -= I_F1;
            if (r < I_F2) { transpose_item(w_ff2 + (size_t)l * DFF * DM, DFF, DM, WFF2 + (size_t)l * DM * DFF, nullptr, 0, scr, r / 32, r % 32, lane); continue; } r -= I_F2;
            transpose_item(s5_w_glu + (size_t)l * 512 * 512, 512, 512, WGLU + (size_t)l * 512 * 512, nullptr, 0, scr, r / 8, r % 8, lane);
        }
        for (int row = gw; row < L + MEMT; row += NGW) {
            const bool ism = row >= L; const int rr = ism ? row - L : row;
            const f32x4* xr = (const f32x4*)((ism ? mem : x_in) + (size_t)rr * DM) + lane; u32x2* ob = (u32x2*)((ism ? MEMB : XB) + (size_t)rr * DM) + lane;
            float s = 0.f;
#pragma unroll
            for (int j = 0; j < 8; ++j) { const f32x4 v = xr[64 * j]; s += (v[0] * v[0] + v[1] * v[1]) + (v[2] * v[2] + v[3] * v[3]); u32x2 w; w.x = cvt_pk_bf16(v[0], v[1]); w.y = cvt_pk_bf16(v[2], v[3]); ob[64 * j] = w; }
            s = wave_sum(s);
            if (ism) { if (lane == 0) RSTDM[rr] = 1.0f / sqrtf(s * (1.0f / DM) + EPS); } else if (lane < 32) SSQ[(size_t)rr * 32 + lane] = lane == 0 ? s : 0.f;
        }
        for (int row = gw; row < DEPTH * DM; row += NGW) {
            const f32x4* xr = (const f32x4*)(xq + (size_t)row * DM) + lane; u32x2* ob = (u32x2*)(WQ + (size_t)row * DM) + lane;
#pragma unroll
            for (int j = 0; j < 8; ++j) { const f32x4 v = xr[64 * j]; u32x2 w; w.x = cvt_pk_bf16(v[0], v[1]); w.y = cvt_pk_bf16(v[2], v[3]); ob[64 * j] = w; }
        }
        const int gt = vcu * (NWAVES * 64) + tid, NGT = G * NWAVES * 64;
        for (int i = gt; i < DEPTH * DM; i += NGT) GXT[i] = norm_xattn[i] * SCL_X;
        for (int i = gt; i < L * 96; i += NGT) {
            int pos, fi, dim; float* dst;
            if (i < L * 64) { pos = i >> 6; fi = i & 63; dim = 128; dst = ROPE128 + (size_t)i * 2; } else { const int k = i - L * 64; pos = k >> 5; fi = k & 31; dim = 64; dst = ROPE64 + (size_t)k * 2; }
            const float ex = -(float)(2 * fi) / (float)dim;
            const float inv = (float)exp2((double)ex * 13.287712379549449);
            const float ang = (float)pos * inv;
            float c, s; cs_reduced((double)ang, c, s); dst[0] = c; dst[1] = s;
        }
        for (int i = gt; i < DEPTH * 32 * 64; i += NGT) {
            const int lg = i >> 6;
            const double dt = exp((double)s5_log_dt[lg]); const double are = (double)s5_a_re[i], aim = (double)s5_a_im[i];
            float* lp = LBP + (size_t)i * 34; float lre = 1.f, lim = 0.f;
            for (int tau = 0; tau <= 16; ++tau) { const float mag = expf((float)(are * dt * tau)); float c, s; cs_reduced(aim * dt * tau, c, s); lp[2 * tau] = mag * c; lp[2 * tau + 1] = mag * s; if (tau == 1) { lre = mag * c; lim = mag * s; } }
            const float ar = (float)are, ai = (float)aim, den = ar * ar + ai * ai;
            const float fre = ((lre - 1.0f) * ar + lim * ai) / den, fim = (lim * ar - (lre - 1.0f) * ai) / den;
            float* bp = BBT + (size_t)i * 32;
            for (int p = 0; p < 16; ++p) { const float br = s5_b_re[(size_t)i * 16 + p], bi = s5_b_im[(size_t)i * 16 + p]; bp[2 * p] = fre * br - fim * bi; bp[2 * p + 1] = fre * bi + fim * br; }
        }
        if (gt < DEPTH) {
            const int l = gt; float s1 = 0.f, s2 = 0.f;
            for (int d = 0; d < 64; ++d) { s1 += lam_q1[l * 64 + d] * lam_k1[l * 64 + d]; s2 += lam_q2[l * 64 + d] * lam_k2[l * 64 + d]; }
            const float lam_init = 0.8f - 0.6f * expf(-0.3f * (float)l);
            LAMT[l] = expf(s1) - expf(s2) + lam_init;
        }
            }
        SEAM(0);
    }
    if (SITE(1) && IN(1)) {
        ENV();
            for (int rep = 0; rep < REPS(1); ++rep) {
            int tid_o = tid_of(W0()); asm volatile("" : "+v"(tid_o)); const int tid = tid_o, lane = tid & 63, wave = __builtin_amdgcn_readfirstlane(tid >> 6), gw = vcu * NWAVES + wave; (void)lane; (void)gw;
        for (int it = (int)blockIdx.x; it < DEPTH * 32; it += G) {
            LAS float* T_lbp = (LAS float*)lds;
            LAS float* T_bb = T_lbp + 64 * 34;
            LAS float* T_c = T_bb + 64 * 32;
            LAS float* T_k = T_c + 16 * 128;
            __syncthreads();
            for (int i = tid; i < 64 * 34; i += 512) T_lbp[i] = LBP[(size_t)it * 64 * 34 + i];
            for (int i = tid; i < 64 * 32; i += 512) T_bb[i] = BBT[(size_t)it * 64 * 32 + i];
            for (int i = tid; i < 16 * 64; i += 512) { T_c[2 * i] = s5_c_re[(size_t)it * 1024 + i]; T_c[2 * i + 1] = s5_c_im[(size_t)it * 1024 + i]; }
            __syncthreads();
            for (int e = tid; e < 4096; e += 512) {
                const int tau = e >> 8, p = (e >> 4) & 15, q = e & 15; float acc = 0.f;
                for (int n = 0; n < 64; ++n) {
                    const float cr = T_c[(p * 64 + n) * 2], ci = T_c[(p * 64 + n) * 2 + 1], lr = T_lbp[(n * 17 + tau) * 2], li = T_lbp[(n * 17 + tau) * 2 + 1], br = T_bb[(n * 16 + q) * 2], bi = T_bb[(n * 16 + q) * 2 + 1];
                    const float tr = cr * lr - ci * li, ti = cr * li + ci * lr;
                    acc += tr * br - ti * bi;
                }
                if (tau == 0 && p == q) acc += s5_d[(size_t)it * 16 + p];
                T_k[e] = acc;
            }
            __syncthreads();
            bf16_t* mf = S5MF + (size_t)it * 256 * 384;
            for (int ch = tid; ch < 256 * 48; ch += 512) {
                const int row = ch / 48, c0 = (ch % 48) * 8, s = row >> 4, p = row & 15; float v[8];
                if (c0 < 256) { const int sp = c0 >> 4, q0 = c0 & 15;
#pragma unroll
                    for (int e = 0; e < 8; ++e) v[e] = (sp <= s) ? T_k[((s - sp) * 16 + p) * 16 + q0 + e] : 0.f; }
                else { const bool im = c0 >= 320; const int n0 = (c0 - 256) & 63;
#pragma unroll
                    for (int e = 0; e < 8; ++e) { const int n = n0 + e; const float cr = T_c[(p * 64 + n) * 2], ci = T_c[(p * 64 + n) * 2 + 1], lr = T_lbp[(n * 17 + s + 1) * 2], li = T_lbp[(n * 17 + s + 1) * 2 + 1];
                        v[e] = im ? -(cr * li + ci * lr) : (cr * lr - ci * li); } }
                u32x4 o; o.x = cvt_pk_bf16(v[0], v[1]); o.y = cvt_pk_bf16(v[2], v[3]); o.z = cvt_pk_bf16(v[4], v[5]); o.w = cvt_pk_bf16(v[6], v[7]);
                *(u32x4*)(mf + (size_t)row * 384 + c0) = o;
            }
            bf16_t* em = S5EM + (size_t)it * 256 * 256;
            for (int ch = tid; ch < 128 * 32; ch += 512) {
                const int row = ch >> 5, c0 = (ch & 31) * 8, n = row & 63, sp = c0 >> 4, q0 = c0 & 15; const bool im = row >= 64; float v[8];
                const float lr = T_lbp[(n * 17 + 15 - sp) * 2], li = T_lbp[(n * 17 + 15 - sp) * 2 + 1];
#pragma unroll
                for (int e = 0; e < 8; ++e) { const float br = T_bb[(n * 16 + q0 + e) * 2], bi = T_bb[(n * 16 + q0 + e) * 2 + 1]; v[e] = im ? (lr * bi + li * br) : (lr * br - li * bi); }
                u32x4 o; o.x = cvt_pk_bf16(v[0], v[1]); o.y = cvt_pk_bf16(v[2], v[3]); o.z = cvt_pk_bf16(v[4], v[5]); o.w = cvt_pk_bf16(v[6], v[7]);
                *(u32x4*)(em + (size_t)row * 256 + c0) = o;
            }
        }
        __syncthreads();
        {
            pg8::Sched S{(const char*)MEMB, (const char*)WK, 0, (long)DM * DM * 2, DM, DM, 1, 8, DEPTH, G, (int)((blockIdx.x + G - G / 2) % G)};
            pg8::EpiMemKV<false> E{RSTDM, KMEM, DM, (long)MEMT * DM};
            pg8::gemm_phase<pg8::EpiMemKV<false>>(lds, DM, S, E, W0());
        }
        {
            pg8::Sched S{(const char*)MEMB, (const char*)WV, 0, (long)DM * DM * 2, DM, DM, 1, 8, DEPTH, G, (int)((blockIdx.x + G - (G / 2 + 32)) % G)};
            pg8::EpiMemKV<false> E{RSTDM, VMEMT, DM, (long)MEMT * DM};
            pg8::gemm_phase<pg8::EpiMemKV<false>>(lds, DM, S, E, W0());
        }
            }
        SEAM(1);
    }
    if (SITE(12) && IN(2)) {
        ENV();
#pragma unroll 1
        for (int l2 = 0; l2 < DEPTH; ++l2) {
            {   pg8::Sched S{(const char*)(KMEM + (size_t)l2 * MEMT * DM), (const char*)(WQ + (size_t)l2 * DM * DM), 512 * 2, 512 * 2, DM, DM, 1, 8, 4, G, (int)((blockIdx.x + G - 32 * l2) % G)};
                pg8::EpiMemKV<true> E{GXT + l2 * DM, XSA + (size_t)l2 * 1024 * DM, DM, (long)MEMT * DM};
                pg8::gemm_phase<pg8::EpiMemKV<true>>(lds, 512, S, E, W0()); }
            {   pg8::Sched S{(const char*)(WO + (size_t)l2 * DM * DM), (const char*)(VMEMT + (size_t)l2 * MEMT * DM), 512 * 2, 512 * 2, DM, DM, 8, 1, 4, G, (int)((blockIdx.x + G - (128 + 32 * l2)) % G)};
                pg8::EpiMemKV<false> E{nullptr, XOB + (size_t)l2 * DM * 1024, 1024, (long)MEMT};
                pg8::gemm_phase<pg8::EpiMemKV<false>>(lds, 512, S, E, W0()); }
        }
        SEAM(2);
    }

    for (int l = 0; l < DEPTH; ++l) {
        const int sb = NSTEP_PRO + l * NSTEP_LAYER;
#define ssq_mix (SSQ + (size_t)(3 * l) * L * 32)
#define ssq_x (SSQ + (size_t)(3 * l + 1) * L * 32)
#define ssq_mlp (SSQ + (size_t)(3 * l + 2) * L * 32)
#define ssq_nxt (SSQ + (size_t)(3 * l + 3) * L * 32)

        if (SITE(2) && IN(sb + 0)) {
            ENV();
            for (int rep = 0; rep < REPS(2); ++rep) {
            pg8::Sched S{(const char*)XB, (const char*)(WIN + (size_t)l * NINP * DM), 0, 0, DM, DM, L / 256, NINP / 256, 1, G, (int)blockIdx.x};
            pg8::EpiInProj E{ssq_mix, ROPE128, ROPE64, QA, KA, VA, QI, KI, S5A, QC, KC, VC, WI, (LAS float*)(lds + EPI_OFF), KMAXP + (size_t)l * 20 * 512};
            pg8::gemm_phase<pg8::EpiInProj>(lds, DM, S, E, W0());
            }
            SEAM(sb + 0);
        }
        if (SITE(3) && IN(sb + 1)) {
            ENV();
            for (int rep = 0; rep < REPS(3); ++rep) {
            if ((int)blockIdx.x >= G - 20) {
                const int slot = (int)blockIdx.x - (G - 20); int t = tid_of(W0()); asm volatile("" : "+v"(t)); LAS float* red = (LAS float*)(lds + EPI_OFF);
                float v = (t < (slot < 16 ? 256 : 512)) ? KMAXP[((size_t)l * 20 + slot) * 512 + t] : 0.f;
                v = wave_max(v); if ((t & 63) == 0) red[t >> 6] = v;
                __syncthreads();
                if (t == 0) { float m = red[0]; for (int i = 1; i < 8; ++i) m = fmaxf(m, red[i]); KMAX2[l * 32 + slot] = m; }
                __syncthreads();
            }
            for (int pi = vcu; pi < 512; pi += G) {
#pragma unroll 1
                for (int k = 0; k < 2; ++k) { const int b = k ? pi : 1023 - pi; dsa::select_block(b * 16, QI, KI, WI, MASK, lds, W0()); }
            }
            }
            SEAM(sb + 1);
        }
        if (SITE(4) && IN(sb + 2)) {
            ENV();
            for (int rep = 0; rep < REPS(4); ++rep) {
            {
            int tid_o = tid_of(W0()); asm volatile("" : "+v"(tid_o)); const int tid = tid_o, lane = tid & 63, wave = __builtin_amdgcn_readfirstlane(tid >> 6), gw = vcu * NWAVES + wave; (void)lane; (void)gw;
            for (int g = vcu; g < 32; g += G) {
                if (SITE(3)) {
                    pg8::Sched S{(const char*)S5A, (const char*)(S5EM + (size_t)l * 32 * 256 * 256), (long)1024 * 384 * 2, (long)256 * 256 * 2, 384, 256, 4, 1, 32, G, 0, 4, 0, 0, g, 1};
                    pg8::EpiS5E E{S5EO};
                    pg8::gemm_phase<pg8::EpiS5E>(lds, 256, S, E, W0());
                }
                asm volatile("s_waitcnt vmcnt(0)" ::: "memory");
                __syncthreads();
                const int n = tid & 63, seg = tid >> 6;
                LAS float* segend = (LAS float*)lds;
                const float* lp = LBP + ((size_t)(l * 32 + g) * 64 + n) * 34;
                const float ar = lp[32], ai = lp[33];
                const float* ep = S5EO + ((size_t)g * 1024 + seg * 128) * 128 + n;
                float xr = 0.f, xi = 0.f;
                for (int j = 0; j < 128; ++j) { const float er = ep[(size_t)j * 128], ei = ep[(size_t)j * 128 + 64]; const float nr = ar * xr - ai * xi + er, ni = ar * xi + ai * xr + ei; xr = nr; xi = ni; }
                __syncthreads();
                segend[(seg * 64 + n) * 2] = xr; segend[(seg * 64 + n) * 2 + 1] = xi;
                __syncthreads();
                float pr = ar, pi = ai;
#pragma unroll
                for (int q = 0; q < 7; ++q) { const float nr = pr * pr - pi * pi, ni = 2.f * pr * pi; pr = nr; pi = ni; }
                xr = 0.f; xi = 0.f;
                for (int s2 = 0; s2 < seg; ++s2) { const float er = segend[(s2 * 64 + n) * 2], ei = segend[(s2 * 64 + n) * 2 + 1]; const float nr = pr * xr - pi * xi + er, ni = pr * xi + pi * xr + ei; xr = nr; xi = ni; }
                bf16_t* xp = S5A + ((size_t)g * 1024 + seg * 128) * 384 + 256 + n;
                for (int j = 0; j < 128; ++j) {
                    xp[(size_t)j * 384] = (bf16_t)(cvt_pk_bf16(xr, 0.f) & 0xffffu); xp[(size_t)j * 384 + 64] = (bf16_t)(cvt_pk_bf16(xi, 0.f) & 0xffffu);
                    const float er = ep[(size_t)j * 128], ei = ep[(size_t)j * 128 + 64]; const float nr = ar * xr - ai * xi + er, ni = ar * xi + ai * xr + ei; xr = nr; xi = ni; }
                asm volatile("s_waitcnt vmcnt(0)" ::: "memory");
                __syncthreads();
                if (SITE(5)) {
                    pg8::Sched S{(const char*)S5A, (const char*)(S5MF + (size_t)l * 32 * 256 * 384), (long)1024 * 384 * 2, (long)256 * 384 * 2, 384, 384, 4, 1, 32, G, 0, 4, 0, 0, g, 1};
                    pg8::EpiS5Y E{YB};
                    pg8::gemm_phase<pg8::EpiS5Y>(lds, 384, S, E, W0());
                }
                asm volatile("s_waitcnt vmcnt(0)" ::: "memory");
                __syncthreads();
                if (tid == 0) { __builtin_amdgcn_fence(__ATOMIC_RELEASE, "agent"); (void)xb_add(ctl + CW_Q + 64 * l + 48, 1u); }
            }
            }
            LAS unsigned* qw = (LAS unsigned*)(lds + LDSCTL_OFF);
            unsigned* qhead = ctl + CW_Q + 64 * l + 16 * rep;
            bool s5_ok = false;
#pragma unroll 1
            for (;;) {
                __syncthreads();
                if (tid_of(W0()) == 0) *qw = __hip_atomic_fetch_add(qhead, 1u, __ATOMIC_RELAXED, __HIP_MEMORY_SCOPE_AGENT);
                __syncthreads();
                const unsigned ui = (unsigned)__builtin_amdgcn_readfirstlane((int)*qw);
                if (ui >= 768u + 128u) break;
                if (ui >= 768u) {
                    if (!s5_ok) {
                        if (tid_of(W0()) == 0) { unsigned* sc_ = ctl + CW_Q + 64 * l + 48; XB_SPIN(xb_ld(sc_) < 32u * (unsigned)(rep + 1), ctl + CW_BAR); __builtin_amdgcn_fence(__ATOMIC_ACQUIRE, "agent"); }
                        __syncthreads(); s5_ok = true;
                    }
                    if (SITE(6)) {
                        const int idx = (int)ui - 768;
                        pg8::Sched S{(const char*)YB, (const char*)(WGLU + (size_t)l * 512 * 512), 0, 0, 512, 512, L / 256, 2, 1, G, 0, 1, idx >> 1, idx & 1, 0};
                        pg8::EpiGLU E{YB, s5_b_glu + l * 512, CAT};
                        pg8::gemm_phase<pg8::EpiGLU>(lds, 512, S, E, W0());
                    }
                    continue;
                }
                const int qb = 63 - (int)(ui / 12u), j = (int)(ui % 12u);
                if (j >= 8) { const int h = j - 8; const float km2 = KMAX2[l * 32 + 16 + h];
                    if (dattn::attn_unit<128, true, true, 0>(QA + h * 128, KA + h * 128, VA + h * 128, CAT + h * 128, MASK, 512, 512, qb * 256, (char*)lds_raw, km2, W0()))
                        (void)dattn::attn_unit<128, true, false, 0>(QA + h * 128, KA + h * 128, VA + h * 128, CAT + h * 128, MASK, 512, 512, qb * 256, (char*)lds_raw, km2, W0()); }
                else {
                    const float lam = LAMT[l], post = 1.0f - (0.8f - 0.6f * expf(-0.3f * (float)l));
                    { const int hh = 2 * j; const float km2 = KMAX2[l * 32 + hh];
                      if (dattn::attn_unit<64, false, true, 1>(QC + hh * 64, KC + hh * 64, VC + j * 128, nullptr, nullptr, 1024, 1024, qb * 256, (char*)lds_raw, km2, W0()))
                          dattn::attn_unit<64, false, false, 1>(QC + hh * 64, KC + hh * 64, VC + j * 128, nullptr, nullptr, 1024, 1024, qb * 256, (char*)lds_raw, km2, W0()); }
                    { const int hh = 2 * j + 1; const float km2 = KMAX2[l * 32 + hh];
                      if (dattn::attn_unit<64, false, true, 2>(QC + hh * 64, KC + hh * 64, VC + j * 128, CAT + 1024 + j * 128, nullptr, 1024, 1024, qb * 256, (char*)lds_raw, km2, W0(), lam, post, subln + l * 128))
                          dattn::attn_unit<64, false, false, 2>(QC + hh * 64, KC + hh * 64, VC + j * 128, CAT + 1024 + j * 128, nullptr, 1024, 1024, qb * 256, (char*)lds_raw, km2, W0(), lam, post, subln + l * 128); }
                }
            }
            }
            SEAM(sb + 2);
        }
        if (SITE(7) && IN(sb + 3)) {
            ENV();
            for (int rep = 0; rep < REPS(7); ++rep) {
            pg8::Sched S{(const char*)CAT, (const char*)(WOUT + (size_t)l * DM * DM), 0, 0, DM, DM, L / 256, DM / 256, 1, G, (int)blockIdx.x};
            pg8::EpiResid E{XB, ssq_x};
            pg8::gemm_phase<pg8::EpiResid>(lds, DM, S, E, W0());
            }
            SEAM(sb + 3);
        }
        if (SITE(8) && IN(sb + 4)) {
            ENV();
            for (int rep = 0; rep < REPS(8); ++rep) {
            pg8::Sched S{(const char*)XB, (const char*)(XSA + (size_t)l * 1024 * DM), 0, (long)MEMT * DM * 2, DM, DM, L / 256, 1, 4, G, (int)blockIdx.x};
            pg8::EpiSoftmax E{ssq_x, PX, (LAS float*)(lds + EPI_OFF)};
            pg8::gemm_phase<pg8::EpiSoftmax>(lds, DM, S, E, W0());
            }
            SEAM(sb + 4);
        }
        if (SITE(9) && IN(sb + 5)) {
            ENV();
            for (int rep = 0; rep < REPS(9); ++rep) {
            pg8::Sched S{(const char*)PX, (const char*)(XOB + (size_t)l * DM * 1024), 0, 0, 1024, 1024, L / 256, DM / 256, 1, G, (int)blockIdx.x};
            pg8::EpiResid E{XB, ssq_mlp};
            pg8::gemm_phase<pg8::EpiResid>(lds, 1024, S, E, W0());
            }
            SEAM(sb + 5);
        }
        if (SITE(10) && IN(sb + 6)) {
            ENV();
            for (int rep = 0; rep < REPS(10); ++rep) {
            pg8::Sched S{(const char*)XB, (const char*)(WFF1 + (size_t)l * DFF * DM), 0, 0, DM, DM, L / 256, DFF / 256, 1, G, (int)blockIdx.x};
            pg8::EpiRowBf16<1> E{ssq_mlp, HID, DFF, 0, (LAS float*)(lds + EPI_OFF)};
            pg8::gemm_phase<pg8::EpiRowBf16<1>>(lds, DM, S, E, W0());
            }
            SEAM(sb + 6);
        }
        if (SITE(11) && IN(sb + 7)) {
            ENV();
            for (int rep = 0; rep < REPS(11); ++rep) {
            pg8::Sched S{(const char*)HID, (const char*)(WFF2 + (size_t)l * DM * DFF), 0, 0, DFF, DFF, L / 256, DM / 256, 1, G, (int)blockIdx.x};
            pg8::EpiResid E{XB, ssq_nxt};
            pg8::gemm_phase<pg8::EpiResid>(lds, DFF, S, E, W0());
            }
            SEAM(sb + 7);
        }
    }
    if (SITE(15) && IN(NSTEPS - 1)) {
        ENV();
            int tid_o = tid_of(W0()); asm volatile("" : "+v"(tid_o)); const int tid = tid_o, lane = tid & 63, wave = __builtin_amdgcn_readfirstlane(tid >> 6), gw = vcu * NWAVES + wave; (void)lane; (void)gw;
        const float* sq = SSQ + (size_t)(3 * DEPTH) * L * 32;
        for (int row = gw; row < L; row += NGW) {
            const float rs = 1.0f / sqrtf(pg8::ssq32(sq + (size_t)row * 32) * (1.0f / DM) + EPS);
            const u32x2* xr = (const u32x2*)(XB + (size_t)row * DM) + lane; f32x4* orow = (f32x4*)(xres + (size_t)row * DM) + lane; const f32x4* gp = (const f32x4*)norm_final + lane;
#pragma unroll
            for (int j = 0; j < 8; ++j) { const u32x2 w = xr[64 * j]; const f32x4 v = {bflo(w.x), bfhi(w.x), bflo(w.y), bfhi(w.y)}; orow[64 * j] = v * rs * gp[64 * j]; }
        }
    }
#undef IN
#undef SEAM
}

#ifndef MK_PER_STEP
#define MK_PER_STEP 0
#endif
extern "C" void kernel_launch(void* const* d_in, const int* in_sizes, int n_in, void* d_out, int out_size, void* d_ws, size_t ws_size, hipStream_t stream) {
    static int grid = 0;
    if (grid == 0) {
        if (n_in != 30 || in_sizes[0] != L * DM || out_size != L * DM || ws_size < WS_END) { fprintf(stderr, "kernel_launch: unexpected shapes (n_in %d, in0 %d, out %d, ws %zu < %zu)\n", n_in, n_in > 0 ? in_sizes[0] : -1, out_size, ws_size, (size_t)WS_END); grid = -1; return; }
        int dev = 0, cus = 0, per_cu = 0;
        if (hipGetDevice(&dev) != hipSuccess || hipDeviceGetAttribute(&cus, hipDeviceAttributeMultiprocessorCount, dev) != hipSuccess) { grid = -1; return; }
        if (hipFuncSetAttribute((const void*)fwd_kernel, hipFuncAttributeMaxDynamicSharedMemorySize, LDS_BYTES) != hipSuccess) { fprintf(stderr, "kernel_launch: hipFuncSetAttribute failed\n"); grid = -1; return; }
        if (hipOccupancyMaxActiveBlocksPerMultiprocessor(&per_cu, (const void*)fwd_kernel, NWAVES * 64, LDS_BYTES) != hipSuccess || per_cu < 1) fprintf(stderr, "kernel_launch: occupancy query reports %d\n", per_cu);
        (void)hipGetLastError();
        grid = cus;
    }
    if (grid < 0) return;
    (void)hipMemsetAsync((char*)d_ws, 0, ZERO_BYTES, stream);
    Args a{};
    for (int i = 0; i < 30; ++i) a.in[i] = (const float*)d_in[i];
    a.out = (float*)d_out; a.ws = (unsigned char*)d_ws;
#if MK_PER_STEP
    for (int s = 0; s < NSTEPS; ++s) { a.ph_lo = s; a.ph_hi = s + 1; hipLaunchKernelGGL(fwd_kernel, dim3(grid), dim3(NWAVES * 64), LDS_BYTES, stream, a); }
#else
    a.ph_lo = 0; a.ph_hi = NSTEPS; hipLaunchKernelGGL(fwd_kernel, dim3(grid), dim3(NWAVES * 64), LDS_BYTES, stream, a);
#endif
    const hipError_t le = hipPeekAtLastError();
    if (le != hipSuccess) fprintf(stderr, "kernel_launch: launch failed: %s\n", hipGetErrorName(le));
}
```

```cpp
#include <hip/hip_runtime.h>
#include <hip/hip_bf16.h>
#include <cstdio>
#include <cstdint>
#include <cmath>

#ifndef EPI_REPS
#define EPI_REPS 1
#endif
#ifndef EPI_KIND
#define EPI_KIND 0
#endif
#define GAS __attribute__((address_space(1)))
#define LAS __attribute__((address_space(3)))

constexpr int L = 16384, DM = 2048, DEPTH = 4, NIN = 5704, NINP = 5888, DFF = 8192, MEMT = 256;
constexpr float EPS = 1e-6f;
constexpr float LOG2E = 1.4426950408889634f;
constexpr float SCL_A = 0.08838834764831845f * LOG2E;
constexpr float SCL_C = 0.125f * LOG2E;
constexpr float SCL_X = 0.04419417382415922f * LOG2E;
constexpr float CIDX = 0.125f * 0.35355339059327373f;

typedef unsigned short bf16_t;
typedef short bf16x8 __attribute__((ext_vector_type(8)));
typedef short s16x4 __attribute__((ext_vector_type(4)));
typedef float f32x4 __attribute__((ext_vector_type(4)));
typedef float f32x2 __attribute__((ext_vector_type(2)));
typedef float f32x16 __attribute__((ext_vector_type(16)));
typedef unsigned u32x4 __attribute__((ext_vector_type(4)));
typedef unsigned u32x2 __attribute__((ext_vector_type(2)));

__device__ __forceinline__ unsigned cvt_pk_bf16(float lo, float hi) { unsigned r; asm volatile("v_cvt_pk_bf16_f32 %0, %1, %2" : "=v"(r) : "v"(lo), "v"(hi)); return r; }
__device__ __forceinline__ float bf2f(unsigned short b) { return __uint_as_float(((unsigned)b) << 16); }
__device__ __forceinline__ float bflo(unsigned w) { return __uint_as_float(w << 16); }
__device__ __forceinline__ float bfhi(unsigned w) { return __uint_as_float(w & 0xffff0000u); }
__device__ __forceinline__ u32x4 pack8(f32x4 a, f32x4 b) { u32x4 w; w.x = cvt_pk_bf16(a[0], a[1]); w.y = cvt_pk_bf16(a[2], a[3]); w.z = cvt_pk_bf16(b[0], b[1]); w.w = cvt_pk_bf16(b[2], b[3]); return w; }

__device__ __forceinline__ int tid_of(int w0) { return (w0 << 6) | (int)__builtin_amdgcn_mbcnt_hi(~0u, __builtin_amdgcn_mbcnt_lo(~0u, 0u)); }

namespace pg8 {
constexpr int BM = 256, BK = 64, HALF = 128, HTB = HALF * BK * 2, STAGE_BYTES = 8 * HTB, NXCD = 8, WGM = 8;
__host__ __device__ __forceinline__ int lds_byte(int r, int c) { const int st = (r >> 4) * 2 + (c >> 5), rr = r & 15, cc = c & 31, ob = rr * 64 + cc * 2; return st * 1024 + (ob ^ (((ob >> 9) & 1) << 5)); }
__host__ __device__ __forceinline__ void stage_rc(int b, int& R, int& C) { const int st = b / 1024, sb = b % 1024, swz = sb ^ (((sb >> 9) & 1) << 5); R = (st >> 1) * 16 + swz / 64; C = (st & 1) * 32 + (swz % 64) / 2; }
__host__ __device__ __forceinline__ int perm32(int rho) { const int n = rho >> 4, i = rho & 15; return 8 * (i >> 2) + 4 * n + (i & 3); }

struct Unit { int pm, pn, z; const char* a; const char* b; };
struct Sched {
    const char* A; const char* B; long sAz, sBz; int lda, ldb;
    int nM, nN, nZ, G, c;
    int cnt = 0, pm0 = 0, pn0 = 0, z0 = 0, lm = 0;
    __device__ __forceinline__ bool next(int i, Unit& u) const {
        const long Lu = (long)i * G + c; const int per = nM * nN; if (cnt > 0 ? i >= cnt : Lu >= (long)per * nZ) return false;
        int pm, pn, z;
        if (cnt > 0) { pm = lm ? pm0 + i : pm0; pn = lm ? pn0 : pn0 + i; z = z0; }
        else if (nZ == 1) {
            const int nwg = per; int wgid = (int)Lu; { const int q = nwg / NXCD, r = nwg % NXCD, xcd = wgid % NXCD, off = wgid / NXCD; wgid = (xcd < r ? xcd * (q + 1) : r * (q + 1) + (xcd - r) * q) + off; }
            const int nig = WGM * nN, gid = wgid / nig, fm = gid * WGM, gsz = (nM - fm) < WGM ? (nM - fm) : WGM;
            pm = fm + ((wgid % nig) % gsz); pn = (wgid % nig) / gsz; z = 0;
        } else { z = (int)(Lu / per); const int w = (int)(Lu % per); pm = w / nN; pn = w % nN; }
        u.pm = pm; u.pn = pn; u.z = z;
        u.a = A + (size_t)z * sAz + (size_t)pm * (size_t)(BM * 2) * lda; u.b = B + (size_t)z * sBz + (size_t)pn * (size_t)(BM * 2) * ldb;
        return true;
    }
};

typedef f32x4 Acc[2][2][4][2];
__device__ __forceinline__ float sum_x16(float x) { auto r = __builtin_amdgcn_permlane16_swap(__float_as_uint(x), __float_as_uint(x), false, false); return __uint_as_float(r[0]) + __uint_as_float(r[1]); }
__device__ __forceinline__ float sum_x32(float x) { auto r = __builtin_amdgcn_permlane32_swap(__float_as_uint(x), __float_as_uint(x), false, false); return __uint_as_float(r[0]) + __uint_as_float(r[1]); }
__device__ __forceinline__ float max_x16(float x) { auto r = __builtin_amdgcn_permlane16_swap(__float_as_uint(x), __float_as_uint(x), false, false); return fmaxf(__uint_as_float(r[0]), __uint_as_float(r[1])); }
__device__ __forceinline__ float max_x32(float x) { auto r = __builtin_amdgcn_permlane32_swap(__float_as_uint(x), __float_as_uint(x), false, false); return fmaxf(__uint_as_float(r[0]), __uint_as_float(r[1])); }
#define EPI_ROWS(ai, m) (u.pm * BM + (ai) * HALF + wr * 64 + (m) * 16 + fr)
#define FOR_AI_M _Pragma("unroll") for (int ai = 0; ai < 2; ++ai) _Pragma("unroll") for (int m = 0; m < 4; ++m)

__device__ __forceinline__ void rope8(f32x4& v0, f32x4& v1, const f32x4 t0, const f32x4 t1) {
    const float a0 = v0[0] * t0[0] - v0[1] * t0[1], a1 = v0[0] * t0[1] + v0[1] * t0[0];
    const float a2 = v0[2] * t0[2] - v0[3] * t0[3], a3 = v0[2] * t0[3] + v0[3] * t0[2];
    const float b0 = v1[0] * t1[0] - v1[1] * t1[1], b1 = v1[0] * t1[1] + v1[1] * t1[0];
    const float b2 = v1[2] * t1[2] - v1[3] * t1[3], b3 = v1[2] * t1[3] + v1[3] * t1[2];
    v0 = (f32x4){a0, a1, a2, a3}; v1 = (f32x4){b0, b1, b2, b3};
}


__device__ __forceinline__ float ssq32(const float* p) {
    float s = 0.f;
#pragma unroll
    for (int i = 0; i < 8; ++i) { const f32x4 v = *(const f32x4*)(p + 4 * i); s += (v[0] + v[1]) + (v[2] + v[3]); }
    return s;
}
__device__ __forceinline__ float row_rstd(const float* ssqp, int row) { return __builtin_amdgcn_rsqf(ssq32(ssqp + (size_t)row * 32) * (1.0f / DM) + EPS); }
__device__ __forceinline__ void rstd_table(const float* ssqp, int row0, LAS float* tab, int wr, int wc, int fr, int fq) {
    const int t = (wr * 4 + wc) * 64 + fq * 16 + fr, row = t >> 1, half = t & 1;
    const float* p = ssqp + (size_t)(row0 + row) * 32 + half * 16; float s = 0.f;
#pragma unroll
    for (int i = 0; i < 4; ++i) { const f32x4 v = *(const f32x4*)(p + 4 * i); s += (v[0] + v[1]) + (v[2] + v[3]); }
    s += __shfl_xor(s, 1);
    if (!half) tab[row] = __builtin_amdgcn_rsqf(s * (1.0f / DM) + EPS);
    asm volatile("s_waitcnt lgkmcnt(0)" ::: "memory"); __builtin_amdgcn_s_barrier(); asm volatile("" ::: "memory");
}
struct EpiInProj {
    static constexpr bool PERM = true, AFTER_DRAIN = false, IDEM = (EPI_KIND == 0 || EPI_KIND == 2);
    const float* ssq; const float* rope128; const float* rope64;
    bf16_t *QA, *KA, *VA, *QI, *KI, *S5A, *QC, *KC, *VC; float* WI; LAS float* tab; float* kmaxp;
    __device__ __forceinline__ void operator()(Acc& acc, const Unit& u, int wr, int wc, int fr, int fq) const {
        const int pn = u.pn;
        bf16_t* dst = QA; int ld = 512, cb = 0, mode = 0;
        if (pn < 2) { dst = QA; cb = pn * 256; mode = 2; }
        else if (pn < 4) { dst = KA; cb = (pn - 2) * 256; mode = 2; }
        else if (pn < 6) { dst = VA; cb = (pn - 4) * 256; mode = 0; }
        else if (pn < 8) { dst = QI; cb = (pn - 6) * 256; mode = 1; }
        else if (pn == 8) { dst = KI; ld = 64; cb = 0; mode = 3; }
        else if (pn < 11) { dst = S5A; cb = (pn - 9) * 256; mode = 4; }
        else if (pn < 15) { dst = QC; ld = 1024; cb = (pn - 11) * 256; mode = 1; }
        else if (pn < 19) { dst = KC; ld = 1024; cb = (pn - 15) * 256; mode = 1; }
        else { dst = VC; ld = 1024; cb = (pn - 19) * 256; mode = 0; }
        rstd_table(ssq, u.pm * BM, tab, wr, wc, fr, fq);
        const int kslot = (pn >= 15 && pn < 19) ? (pn - 15) * 4 : ((pn >= 2 && pn < 4) ? 16 + (pn - 2) * 2 : -1);
        float kmx0 = 0.f, kmx1 = 0.f;
        FOR_AI_M {
            const int row = EPI_ROWS(ai, m);
            const float rs = tab[ai * HALF + wr * 64 + m * 16 + fr];
#pragma unroll
            for (int bj = 0; bj < 2; ++bj) {
                const int cl = cb + bj * HALF + wc * 32 + 8 * fq;
                f32x4 v0 = acc[ai][bj][m][0] * rs, v1 = acc[ai][bj][m][1] * rs;
                if (mode == 3) {
                    if (cl < 64) { const float* tp = rope64 + ((size_t)row * 32 + (cl >> 1)) * 2; rope8(v0, v1, *(const f32x4*)tp, *(const f32x4*)(tp + 4));
                        *(u32x4*)(KI + (size_t)row * 64 + cl) = pack8(v0, v1); }
                    else if (cl == 64) { *(f32x4*)(WI + (size_t)row * 8) = v0 * CIDX; *(f32x4*)(WI + (size_t)row * 8 + 4) = v1 * CIDX; }
                } else if (mode == 4) {
                    const int g = cl >> 4, p0 = cl & 15, j = row >> 4, s = row & 15;
                    *(u32x4*)(S5A + ((size_t)(g * 1024 + j) * 384) + s * 16 + p0) = pack8(v0, v1);
                } else {
                    if (mode == 1) { const float* tp = rope64 + ((size_t)row * 32 + ((cl & 63) >> 1)) * 2; rope8(v0, v1, *(const f32x4*)tp, *(const f32x4*)(tp + 4)); }
                    else if (mode == 2) { const float* tp = rope128 + ((size_t)row * 64 + ((cl & 127) >> 1)) * 2; rope8(v0, v1, *(const f32x4*)tp, *(const f32x4*)(tp + 4)); }
                    *(u32x4*)(dst + (size_t)row * ld + cl) = pack8(v0, v1);
                    if (kslot >= 0) { float ss = (v0[0] * v0[0] + v0[1] * v0[1]) + (v0[2] * v0[2] + v0[3] * v0[3]) + (v1[0] * v1[0] + v1[1] * v1[1]) + (v1[2] * v1[2] + v1[3] * v1[3]);
                        ss = sum_x16(ss); ss = sum_x32(ss); if (bj == 0) kmx0 = fmaxf(kmx0, ss); else kmx1 = fmaxf(kmx1, ss); }
                }
            }
        }
        if (kslot >= 0) {
#pragma unroll
            for (int o = 1; o < 16; o <<= 1) { kmx0 = fmaxf(kmx0, __shfl_xor(kmx0, o)); kmx1 = fmaxf(kmx1, __shfl_xor(kmx1, o)); }
            if (fr == 0 && fq == 0) { const int s0 = kslot < 16 ? kslot + (wc >> 1) : kslot, s1 = kslot < 16 ? kslot + 2 + (wc >> 1) : kslot + 1;
                const int ix = kslot < 16 ? u.pm * 4 + wr * 2 + (wc & 1) : u.pm * 8 + wr * 4 + wc;
                kmaxp[s0 * 512 + ix] = kmx0; kmaxp[s1 * 512 + ix] = kmx1; }
        }
    }
};

struct EpiResid {
    static constexpr bool PERM = true, AFTER_DRAIN = false, IDEM = false;
    bf16_t* xb; float* ssq_next;
    __device__ __forceinline__ void operator()(Acc& acc, const Unit& u, int wr, int wc, int fr, int fq) const {
        FOR_AI_M {
            const int row = EPI_ROWS(ai, m); float sq = 0.f;
#pragma unroll
            for (int bj = 0; bj < 2; ++bj) {
                const size_t off = (size_t)row * DM + u.pn * BM + bj * HALF + wc * 32 + 8 * fq;
                const u32x4 xw = *(const u32x4*)(xb + off);
                const f32x4 a0 = acc[ai][bj][m][0], a1 = acc[ai][bj][m][1];
                const u32x4 w = pack8((f32x4){bflo(xw.x) + a0[0], bfhi(xw.x) + a0[1], bflo(xw.y) + a0[2], bfhi(xw.y) + a0[3]}, (f32x4){bflo(xw.z) + a1[0], bfhi(xw.z) + a1[1], bflo(xw.w) + a1[2], bfhi(xw.w) + a1[3]});
                *(u32x4*)(xb + off) = w;
                const float v0 = bflo(w.x), v1 = bfhi(w.x), v2 = bflo(w.y), v3 = bfhi(w.y), v4 = bflo(w.z), v5 = bfhi(w.z), v6 = bflo(w.w), v7 = bfhi(w.w);
                sq += ((v0 * v0 + v1 * v1) + (v2 * v2 + v3 * v3)) + ((v4 * v4 + v5 * v5) + (v6 * v6 + v7 * v7));
            }
            sq = sum_x16(sq); sq = sum_x32(sq);
            if (fq == 0) ssq_next[(size_t)row * 32 + u.pn * 4 + wc] = sq;
            asm volatile("" ::: "memory");
        }
    }
};

template <int ACT> struct EpiRowBf16 {
    static constexpr bool PERM = true, AFTER_DRAIN = false, IDEM = (EPI_KIND == 0 || EPI_KIND == 1);
    const float* ssq; bf16_t* O; int ldc; int zcols; LAS float* tab;
    __device__ __forceinline__ void operator()(Acc& acc, const Unit& u, int wr, int wc, int fr, int fq) const {
        if (ssq) rstd_table(ssq, u.pm * BM, tab, wr, wc, fr, fq);
        FOR_AI_M {
            const int row = EPI_ROWS(ai, m);
            const float rs = ssq ? tab[ai * HALF + wr * 64 + m * 16 + fr] : 1.0f;
#pragma unroll
            for (int bj = 0; bj < 2; ++bj) {
                f32x4 v0 = acc[ai][bj][m][0] * rs, v1 = acc[ai][bj][m][1] * rs;
                if (ACT == 1) {
#pragma unroll
                    for (int e = 0; e < 4; ++e) { const float a = fmaxf(v0[e], 0.f), b = fmaxf(v1[e], 0.f); v0[e] = a * a; v1[e] = b * b; }
                }
                *(u32x4*)(O + (size_t)row * ldc + u.z * zcols + u.pn * BM + bj * HALF + wc * 32 + 8 * fq) = pack8(v0, v1);
            }
        }
    }
};

template <bool COLSCALE> struct EpiMemKV {
    static constexpr bool PERM = true, AFTER_DRAIN = false, IDEM = (EPI_KIND == 0);
    const float* rstd; bf16_t* O; int ldc; long zstride;
    __device__ __forceinline__ void operator()(Acc& acc, const Unit& u, int wr, int wc, int fr, int fq) const {
        FOR_AI_M {
            const int row = EPI_ROWS(ai, m);
#pragma unroll
            for (int bj = 0; bj < 2; ++bj) {
                const int col = u.pn * BM + bj * HALF + wc * 32 + 8 * fq;
                f32x4 v0 = acc[ai][bj][m][0], v1 = acc[ai][bj][m][1];
                if (COLSCALE) { v0 = v0 * *(const f32x4*)(rstd + col); v1 = v1 * *(const f32x4*)(rstd + col + 4); }
                else if (rstd) { const float rs = rstd[row]; v0 = v0 * rs; v1 = v1 * rs; }
                *(u32x4*)(O + (size_t)u.z * zstride + (size_t)row * ldc + col) = pack8(v0, v1);
            }
        }
    }
};

struct EpiS5E {
    static constexpr bool PERM = false, AFTER_DRAIN = false, IDEM = (EPI_KIND == 0);
    float* E;
    __device__ __forceinline__ void operator()(Acc& acc, const Unit& u, int wr, int wc, int fr, int fq) const {
        FOR_AI_M {
            const int row = EPI_ROWS(ai, m);
#pragma unroll
            for (int n = 0; n < 2; ++n) *(f32x4*)(E + ((size_t)u.z * 1024 + row) * 128 + wc * 32 + n * 16 + 4 * fq) = acc[ai][0][m][n];
        }
    }
};

__device__ __forceinline__ float gelu_tanh(float x) {
    const float t = 1.5957691216057308f * (x + 0.044715f * x * x * x);
    return x * __builtin_amdgcn_rcpf(1.0f + __builtin_amdgcn_exp2f(-t * LOG2E));
}
struct EpiS5Y {
    static constexpr bool PERM = true, AFTER_DRAIN = false, IDEM = (EPI_KIND == 0);
    bf16_t* YB;
    __device__ __forceinline__ void operator()(Acc& acc, const Unit& u, int wr, int wc, int fr, int fq) const {
        FOR_AI_M {
            const int j = EPI_ROWS(ai, m);
#pragma unroll
            for (int bj = 0; bj < 2; ++bj) {
                const int col = bj * HALF + wc * 32 + 8 * fq, s = col >> 4, p0 = col & 15;
                f32x4 v0 = acc[ai][bj][m][0], v1 = acc[ai][bj][m][1];
#pragma unroll
                for (int e = 0; e < 4; ++e) { v0[e] = gelu_tanh(v0[e]); v1[e] = gelu_tanh(v1[e]); }
                *(u32x4*)(YB + (size_t)(16 * j + s) * 512 + 16 * u.z + p0) = pack8(v0, v1);
            }
        }
    }
};
struct EpiGLU {
    static constexpr bool PERM = true, AFTER_DRAIN = false, IDEM = (EPI_KIND == 0);
    const bf16_t* YB; const float* bias; bf16_t* CAT;
    __device__ __forceinline__ void operator()(Acc& acc, const Unit& u, int wr, int wc, int fr, int fq) const {
        FOR_AI_M {
            const int row = EPI_ROWS(ai, m);
#pragma unroll
            for (int bj = 0; bj < 2; ++bj) {
                const int col = u.pn * BM + bj * HALF + wc * 32 + 8 * fq;
                const u32x4 yw = *(const u32x4*)(YB + (size_t)row * 512 + col);
                const f32x4 b0 = *(const f32x4*)(bias + col), b1 = *(const f32x4*)(bias + col + 4);
                f32x4 g0 = acc[ai][bj][m][0] + b0, g1 = acc[ai][bj][m][1] + b1;
                const float y[8] = {bflo(yw.x), bfhi(yw.x), bflo(yw.y), bfhi(yw.y), bflo(yw.z), bfhi(yw.z), bflo(yw.w), bfhi(yw.w)};
#pragma unroll
                for (int e = 0; e < 4; ++e) { g0[e] = y[e] * __builtin_amdgcn_rcpf(1.0f + __builtin_amdgcn_exp2f(-g0[e] * LOG2E)); g1[e] = y[4 + e] * __builtin_amdgcn_rcpf(1.0f + __builtin_amdgcn_exp2f(-g1[e] * LOG2E)); }
                *(u32x4*)(CAT + (size_t)row * DM + 512 + col) = pack8(g0, g1);
            }
        }
    }
};
struct EpiSoftmax {
    static constexpr bool PERM = true, AFTER_DRAIN = false, IDEM = false;
    const float* ssq; bf16_t* PX; LAS float* red;
    __device__ __forceinline__ void operator()(Acc& acc, const Unit& u, int wr, int wc, int fr, int fq) const {
        LAS float* red2 = red + 1024;
        rstd_table(ssq, u.pm * BM, red2, wr, wc, fr, fq);
        float rsv[2][4];
        FOR_AI_M {
            const int rt = ai * HALF + wr * 64 + m * 16 + fr; float mx = -3.0e38f; rsv[ai][m] = red2[rt];
#pragma unroll
            for (int bj = 0; bj < 2; ++bj)
#pragma unroll
                for (int n = 0; n < 2; ++n) { const f32x4 v = acc[ai][bj][m][n]; mx = fmaxf(mx, fmaxf(fmaxf(v[0], v[1]), fmaxf(v[2], v[3]))); }
            mx = max_x16(mx); mx = max_x32(mx);
            if (fq == 0) red[rt * 4 + wc] = mx;
        }
        asm volatile("s_waitcnt lgkmcnt(0)" ::: "memory"); __builtin_amdgcn_s_barrier(); asm volatile("" ::: "memory");
        FOR_AI_M {
            const int rt = ai * HALF + wr * 64 + m * 16 + fr; const f32x4 r4 = *(const LAS f32x4*)(red + rt * 4);
            const float mx = fmaxf(fmaxf(r4[0], r4[1]), fmaxf(r4[2], r4[3])); float sm = 0.f;
#pragma unroll
            for (int bj = 0; bj < 2; ++bj)
#pragma unroll
                for (int n = 0; n < 2; ++n) { f32x4 v = acc[ai][bj][m][n];
#pragma unroll
                    for (int e = 0; e < 4; ++e) { v[e] = __builtin_amdgcn_exp2f((v[e] - mx) * rsv[ai][m]); sm += v[e]; }
                    acc[ai][bj][m][n] = v; }
            sm = sum_x16(sm); sm = sum_x32(sm);
            if (fq == 0) red2[rt * 4 + wc] = sm;
        }
        asm volatile("s_waitcnt lgkmcnt(0)" ::: "memory"); __builtin_amdgcn_s_barrier(); asm volatile("" ::: "memory");
        FOR_AI_M {
            const int rt = ai * HALF + wr * 64 + m * 16 + fr; const f32x4 r4 = *(const LAS f32x4*)(red2 + rt * 4);
            const float inv = __builtin_amdgcn_rcpf((r4[0] + r4[1]) + (r4[2] + r4[3]));
            const int row = u.pm * BM + rt;
#pragma unroll
            for (int bj = 0; bj < 2; ++bj)
                *(u32x4*)(PX + (size_t)row * 1024 + u.z * 256 + bj * HALF + wc * 32 + 8 * fq) = pack8(acc[ai][bj][m][0] * inv, acc[ai][bj][m][1] * inv);
        }
    }
};
template <class Epi, bool ALIGN_EPI = true, bool SP2 = true>
__device__ __forceinline__ void gemm_phase(LAS unsigned char* lds, const int K, const Sched& S0, const Epi& E, const int w0) {
    Sched S = S0; { int c_ = S0.c; asm volatile("" : "+s"(c_)); S.c = c_; }
    int tid_ = tid_of(w0); asm volatile("" : "+v"(tid_));
    const int tid = tid_, wid = __builtin_amdgcn_readfirstlane(tid >> 6), lane = tid & 63, wr = wid >> 2, wc = wid & 3, fr = lane & 15, fq = lane >> 4;
    const int nt = K / BK; const int lda = S.lda, ldb = S.ldb;
    unsigned voffA[2], voffB[2];
#pragma unroll
    for (int i = 0; i < 2; ++i) { int R, C; stage_rc(tid * 16 + i * 8192, R, C); const int Rb = Epi::PERM ? ((R & ~31) + perm32(R & 31)) : R;
        voffA[i] = (unsigned)(R * lda + C) * 2u; voffB[i] = (unsigned)(Rb * ldb + C) * 2u; }
    const size_t kstep = (size_t)(BK * 2);
    const size_t hstepA = (size_t)HALF * lda * 2, hstepB = (size_t)HALF * ldb * 2;
    const unsigned ldsw = (unsigned)wid * 1024u;
    const int aoff = lds_byte(wr * 64 + fr, fq * 8), boff = lds_byte(wc * 32 + fr, fq * 8);
#define PG8_SA(b, h) (((b) * 2 + (h)) * HTB)
#define PG8_SB(b, h) ((4 + (b) * 2 + (h)) * HTB)
#define PG8_STAGE(bufoff, gbase, voff) do { _Pragma("unroll") for (int _i = 0; _i < 2; ++_i) \
        __builtin_amdgcn_global_load_lds((const unsigned*)((const char*)(gbase) + (voff)[_i]), (LAS unsigned*)(lds + (bufoff) + ldsw + _i * 8192), 16, 0, 0); } while (0)
#define PG8_LDA(dst, b, h) do { _Pragma("unroll") for (int m = 0; m < 4; ++m) _Pragma("unroll") for (int k = 0; k < 2; ++k) dst[m][k] = *(const LAS bf16x8*)(lds + PG8_SA(b, h) + aoff + m * 2048 + k * 1024); } while (0)
#define PG8_LDB(dst, b, h) do { _Pragma("unroll") for (int n = 0; n < 2; ++n) _Pragma("unroll") for (int k = 0; k < 2; ++k) dst[n][k] = *(const LAS bf16x8*)(lds + PG8_SB(b, h) + boff + n * 2048 + k * 1024); } while (0)
#define PG8_MMA(ai, bj, At, Bt) do { __builtin_amdgcn_s_setprio(1); _Pragma("unroll") for (int m = 0; m < 4; ++m) _Pragma("unroll") for (int n = 0; n < 2; ++n) _Pragma("unroll") for (int k = 0; k < 2; ++k) \
        acc[ai][bj][m][n] = __builtin_amdgcn_mfma_f32_16x16x32_bf16(Bt[n][k], At[m][k], acc[ai][bj][m][n], 0, 0, 0); __builtin_amdgcn_s_setprio(0); } while (0)
#define PG8_WAIT_V(n) asm volatile("s_waitcnt vmcnt(" #n ")" ::: "memory")
#define PG8_WAIT_L(n) asm volatile("s_waitcnt lgkmcnt(" #n ")" ::: "memory")
#define PG8_BAR __builtin_amdgcn_s_barrier()
#define PG8_SCHED __builtin_amdgcn_sched_barrier(0)
    Unit cur, nxt; int ui = 0;
    if (!S.next(0, cur)) return;
    f32x4 acc[2][2][4][2];
#pragma unroll
    for (int a = 0; a < 2; ++a)
#pragma unroll
        for (int b = 0; b < 2; ++b)
#pragma unroll
            for (int m = 0; m < 4; ++m)
#pragma unroll
                for (int n = 0; n < 2; ++n) acc[a][b][m][n] = (f32x4){0.f, 0.f, 0.f, 0.f};
    bf16x8 At[4][2], B0[2][2], B1[2][2];
    const char* cA = cur.a; const char* cB = cur.b;
    if constexpr (SP2) {
        PG8_STAGE(PG8_SB(0, 0), cB, voffB); PG8_STAGE(PG8_SB(0, 1), cB + hstepB, voffB); PG8_STAGE(PG8_SA(0, 0), cA, voffA); PG8_STAGE(PG8_SA(0, 1), cA + hstepA, voffA);
        if (wr == 1) PG8_BAR;
        PG8_WAIT_V(2); PG8_BAR;
        PG8_STAGE(PG8_SB(1, 0), cB + kstep, voffB); PG8_STAGE(PG8_SA(1, 0), cA + kstep, voffA); PG8_STAGE(PG8_SB(1, 1), cB + hstepB + kstep, voffB);
        PG8_WAIT_V(6); PG8_BAR;
    } else {
        PG8_STAGE(PG8_SB(0, 0), cB, voffB); PG8_STAGE(PG8_SA(0, 0), cA, voffA); PG8_STAGE(PG8_SB(0, 1), cB + hstepB, voffB); PG8_STAGE(PG8_SA(0, 1), cA + hstepA, voffA);
        if (wr == 1) PG8_BAR;
        PG8_WAIT_V(4); PG8_BAR;
        PG8_STAGE(PG8_SB(1, 0), cB + kstep, voffB); PG8_STAGE(PG8_SA(1, 0), cA + kstep, voffA); PG8_STAGE(PG8_SB(1, 1), cB + hstepB + kstep, voffB);
        PG8_WAIT_V(6); PG8_BAR;
    }
    for (;;) {
        const bool has_next = S.next(ui + 1, nxt);
        const char* nA = has_next ? nxt.a : cA; const char* nB = has_next ? nxt.b : cB;
#pragma unroll 1
        for (int t = 0; t < nt; t += 2) {
            const bool last = (t == nt - 2);
            const char* a1 = cA + (size_t)(t + 1) * kstep;
            const char* a2 = last ? nA : cA + (size_t)(t + 2) * kstep; const char* b2 = last ? nB : cB + (size_t)(t + 2) * kstep;
            const char* a3 = a2 + kstep; const char* b3 = b2 + kstep;
            if constexpr (SP2) {
            PG8_LDB(B0, 0, 0); PG8_LDB(B1, 0, 1); PG8_SCHED; PG8_LDA(At, 0, 0); PG8_STAGE(PG8_SA(1, 1), a1 + hstepA, voffA);
            PG8_WAIT_V(8); PG8_WAIT_L(0); PG8_BAR; PG8_MMA(0, 0, At, B0); PG8_MMA(0, 1, At, B1); PG8_BAR; PG8_SCHED;
            PG8_LDA(At, 0, 1); PG8_STAGE(PG8_SB(0, 0), b2, voffB); PG8_STAGE(PG8_SB(0, 1), b2 + hstepB, voffB); PG8_STAGE(PG8_SA(0, 0), a2, voffA);
            PG8_WAIT_V(8); PG8_WAIT_L(0); PG8_BAR; PG8_MMA(1, 0, At, B0); PG8_MMA(1, 1, At, B1); PG8_BAR; PG8_SCHED;
            PG8_LDB(B0, 1, 0); PG8_LDB(B1, 1, 1); PG8_SCHED; PG8_LDA(At, 1, 0); PG8_STAGE(PG8_SA(0, 1), a2 + hstepA, voffA);
            PG8_WAIT_V(8); PG8_WAIT_L(0); PG8_BAR; PG8_MMA(0, 0, At, B0); PG8_MMA(0, 1, At, B1); PG8_BAR; PG8_SCHED;
            PG8_LDA(At, 1, 1); PG8_STAGE(PG8_SB(1, 0), b3, voffB); PG8_STAGE(PG8_SB(1, 1), b3 + hstepB, voffB); PG8_STAGE(PG8_SA(1, 0), a3, voffA);
            PG8_WAIT_V(8); PG8_WAIT_L(0); PG8_BAR; PG8_MMA(1, 0, At, B0); PG8_MMA(1, 1, At, B1); PG8_BAR; PG8_SCHED;
            } else {
            PG8_LDB(B0, 0, 0); PG8_SCHED; PG8_LDA(At, 0, 0); PG8_STAGE(PG8_SA(1, 1), a1 + hstepA, voffA);
            PG8_WAIT_L(8); PG8_BAR; PG8_WAIT_L(0); PG8_MMA(0, 0, At, B0); PG8_BAR; PG8_SCHED;
            PG8_LDB(B1, 0, 1); PG8_STAGE(PG8_SB(0, 0), b2, voffB);
            PG8_BAR; PG8_WAIT_L(0); PG8_MMA(0, 1, At, B1); PG8_BAR;
            PG8_LDA(At, 0, 1); PG8_STAGE(PG8_SA(0, 0), a2, voffA);
            PG8_BAR; PG8_WAIT_L(0); PG8_MMA(1, 0, At, B0); PG8_BAR; PG8_SCHED;
            PG8_STAGE(PG8_SB(0, 1), b2 + hstepB, voffB);
            PG8_WAIT_V(6); PG8_BAR; PG8_MMA(1, 1, At, B1); PG8_BAR;
            PG8_LDB(B0, 1, 0); PG8_SCHED; PG8_LDA(At, 1, 0); PG8_STAGE(PG8_SA(0, 1), a2 + hstepA, voffA);
            PG8_WAIT_L(8); PG8_BAR; PG8_WAIT_L(0); PG8_MMA(0, 0, At, B0); PG8_BAR; PG8_SCHED;
            PG8_LDB(B1, 1, 1); PG8_STAGE(PG8_SB(1, 0), b3, voffB);
            PG8_BAR; PG8_WAIT_L(0); PG8_MMA(0, 1, At, B1); PG8_BAR;
            PG8_LDA(At, 1, 1); PG8_STAGE(PG8_SA(1, 0), a3, voffA);
            PG8_BAR; PG8_WAIT_L(0); PG8_MMA(1, 0, At, B0); PG8_BAR; PG8_SCHED;
            PG8_STAGE(PG8_SB(1, 1), b3 + hstepB, voffB);
            PG8_WAIT_V(6); PG8_BAR; PG8_MMA(1, 1, At, B1); PG8_BAR;
            }
        }
        if constexpr (ALIGN_EPI) { if (wr == 0) PG8_BAR; }
        if constexpr (!Epi::AFTER_DRAIN) { _Pragma("unroll 1") for (int er_ = 0; er_ < (Epi::IDEM ? EPI_REPS : 1); ++er_) E(acc, cur, wr, wc, fr, fq); }
        if (!has_next) break;
#pragma unroll
        for (int a = 0; a < 2; ++a)
#pragma unroll
            for (int b = 0; b < 2; ++b)
#pragma unroll
                for (int m = 0; m < 4; ++m)
#pragma unroll
                    for (int n = 0; n < 2; ++n) acc[a][b][m][n] = (f32x4){0.f, 0.f, 0.f, 0.f};
        cur = nxt; cA = nA; cB = nB; ++ui;
        if constexpr (ALIGN_EPI) { if (wr == 1) PG8_BAR; }
    }
    PG8_WAIT_V(0);
    if constexpr (!ALIGN_EPI) { if (wr == 0) PG8_BAR; }
    PG8_BAR;
    if constexpr (Epi::AFTER_DRAIN) { E.fused(acc, cur, wr, wc, fr, fq, lds, wid, lane); }
#undef PG8_SA
#undef PG8_SB
#undef PG8_STAGE
#undef PG8_LDA
#undef PG8_LDB
#undef PG8_MMA
#undef PG8_WAIT_V
#undef PG8_WAIT_L
#undef PG8_BAR
#undef PG8_SCHED
}
}

namespace dattn {
constexpr int NW = 8, QBLK = 32, KVBLK = 64, LDO = 2048;
constexpr float THR = 8.f * 1.4426950408889634f;
constexpr int SHM_V = KVBLK * 128 * 2;
constexpr int STASH_OFF = 77824;
#define KSWZ(row, colB) ((row) * (DQK * 2) + ((colB) ^ ((DQK == 64 ? (((row) >> 1) & 7) : ((row) & 15)) << 4)))
#define SBAR() __builtin_amdgcn_sched_barrier(0)
__device__ __forceinline__ int crow(int r, int hi) { return (r & 3) + 8 * (r >> 2) + 4 * hi; }
template <bool REL>
__device__ __forceinline__ void partialSM(f32x16& p0, f32x16& p1, float& m_reg, float& mn, float& alpha) {
  if (REL) {
#pragma unroll
    for (int r = 0; r < 16; ++r) p0[r] = p0[r] - m_reg;
#pragma unroll
    for (int r = 0; r < 16; ++r) p1[r] = p1[r] - m_reg;
    float pmax = p0[0];
#pragma unroll
    for (int r = 1; r < 16; ++r) pmax = fmaxf(pmax, p0[r]);
#pragma unroll
    for (int r = 0; r < 16; ++r) pmax = fmaxf(pmax, p1[r]);
    { auto rr = __builtin_amdgcn_permlane32_swap(__float_as_uint(pmax), __float_as_uint(pmax), false, false);
      pmax = fmaxf(__uint_as_float(rr[0]), __uint_as_float(rr[1])); }
    if (__builtin_expect(__all(pmax <= THR), 1)) { mn = m_reg; alpha = 1.f; }
    else { const float d = fmaxf(pmax, 0.f); mn = m_reg + d; alpha = __builtin_amdgcn_exp2f(-d); m_reg = mn;
#pragma unroll
      for (int r = 0; r < 16; ++r) { p0[r] = p0[r] - d; p1[r] = p1[r] - d; } }
  } else {
    float pmax = p0[0];
#pragma unroll
    for (int r = 1; r < 16; ++r) pmax = fmaxf(pmax, p0[r]);
#pragma unroll
    for (int r = 0; r < 16; ++r) pmax = fmaxf(pmax, p1[r]);
    { auto rr = __builtin_amdgcn_permlane32_swap(__float_as_uint(pmax), __float_as_uint(pmax), false, false);
      pmax = fmaxf(__uint_as_float(rr[0]), __uint_as_float(rr[1])); }
    if (__builtin_expect(__all(pmax - m_reg <= THR), 1)) { mn = m_reg; alpha = 1.f; }
    else { mn = fmaxf(m_reg, pmax); alpha = __builtin_amdgcn_exp2f(m_reg - mn); m_reg = mn; }
#pragma unroll
    for (int r = 0; r < 16; ++r) p0[r] = p0[r] - mn;
#pragma unroll
    for (int r = 0; r < 16; ++r) p1[r] = p1[r] - mn;
  }
#pragma unroll
  for (int r = 0; r < 16; ++r) p0[r] = __builtin_amdgcn_exp2f(p0[r]);
}
__device__ __forceinline__ void finishSM(f32x16& p0, f32x16& p1, float alpha, float& l_reg, bf16x8& pa0, bf16x8& pa1, bf16x8& pa2, bf16x8& pa3) {
#pragma unroll
  for (int r = 0; r < 16; ++r) p1[r] = __builtin_amdgcn_exp2f(p1[r]);
  float ps = 0;
#pragma unroll
  for (int r = 0; r < 16; ++r) ps += p0[r];
#pragma unroll
  for (int r = 0; r < 16; ++r) ps += p1[r];
  { auto rr = __builtin_amdgcn_permlane32_swap(__float_as_uint(ps), __float_as_uint(ps), false, false);
    ps = __uint_as_float(rr[0]) + __uint_as_float(rr[1]); }
  l_reg = l_reg * alpha + ps;
#define PK4(P, BASE, OUT) do { unsigned a0 = cvt_pk_bf16(P[BASE + 0], P[BASE + 1]), a1 = cvt_pk_bf16(P[BASE + 2], P[BASE + 3]);   \
    unsigned b0 = cvt_pk_bf16(P[BASE + 4], P[BASE + 5]), b1 = cvt_pk_bf16(P[BASE + 6], P[BASE + 7]);                              \
    auto r0 = __builtin_amdgcn_permlane32_swap(a0, b0, false, false); auto r1 = __builtin_amdgcn_permlane32_swap(a1, b1, false, false); \
    u32x4 w = {r0[0], r1[0], r0[1], r1[1]}; OUT = *reinterpret_cast<bf16x8*>(&w); } while (0)
  PK4(p0, 0, pa0); PK4(p0, 8, pa1); PK4(p1, 0, pa2); PK4(p1, 8, pa3);
#undef PK4
}
template <int DQK, bool MASKED, bool FIXM>
__device__ __forceinline__ void qkt(f32x16& p0, f32x16& p1, const char* Ks, const bf16x8* qr, int r32, int hi, bool valid, unsigned w0, unsigned w1, float negb) {
  const unsigned nb = FIXM ? __float_as_uint(negb) : 0u;
  if (MASKED && FIXM) {
    const unsigned na0 = ~(w0 >> (4 * hi)), na1 = ~(w1 >> (4 * hi));
#pragma unroll
    for (int r = 0; r < 16; ++r) { const int bit = (r & 3) + 8 * (r >> 2);
      const int x0 = __builtin_amdgcn_sbfe((int)na0, bit, 1), x1 = __builtin_amdgcn_sbfe((int)na1, bit, 1); unsigned y0, y1;
      asm("v_and_b32 %0, %1, %2" : "=v"(y0) : "s"(0xff800000u), "v"(x0)); asm("v_and_b32 %0, %1, %2" : "=v"(y1) : "s"(0xff800000u), "v"(x1));
      p0[r] = __uint_as_float(y0); p1[r] = __uint_as_float(y1); }
  } else if (MASKED) {
    const unsigned a0 = w0 >> (4 * hi), a1 = w1 >> (4 * hi);
#pragma unroll
    for (int r = 0; r < 16; ++r) { const int bit = (r & 3) + 8 * (r >> 2);
      const unsigned x0 = (unsigned)__builtin_amdgcn_sbfe((int)a0, bit, 1), x1 = (unsigned)__builtin_amdgcn_sbfe((int)a1, bit, 1);
      p0[r] = __uint_as_float((x0 & nb) | (0xff800000u & ~x0));
      p1[r] = __uint_as_float((x1 & nb) | (0xff800000u & ~x1)); }
  } else {
#pragma unroll
    for (int r = 0; r < 16; ++r) { p0[r] = __uint_as_float(nb); p1[r] = __uint_as_float(nb); } }
  if (valid) {
#pragma unroll
    for (int d0 = 0; d0 < DQK / 16; ++d0) { const int cb = (d0 * 16 + hi * 8) * 2;
      bf16x8 b0 = *reinterpret_cast<const bf16x8*>(Ks + KSWZ(r32, cb));
      bf16x8 b1 = *reinterpret_cast<const bf16x8*>(Ks + KSWZ(32 + r32, cb));
      p0 = __builtin_amdgcn_mfma_f32_32x32x16_bf16(b0, qr[d0], p0, 0, 0, 0);
      p1 = __builtin_amdgcn_mfma_f32_32x32x16_bf16(b1, qr[d0], p1, 0, 0, 0); }
  } else {
#pragma unroll
    for (int r = 0; r < 16; ++r) { p0[r] = -INFINITY; p1[r] = -INFINITY; } }
}
template <int DQK, bool FIXM>
__device__ __forceinline__ void qkt_r(f32x16& p0, f32x16& p1, const bf16x8* kf, const char* Ks, const bf16x8* qr, int r32, int hi, bool valid, float negb) {
  const unsigned nb = FIXM ? __float_as_uint(negb) : 0u;
#pragma unroll
  for (int r = 0; r < 16; ++r) { p0[r] = __uint_as_float(nb); p1[r] = __uint_as_float(nb); }
#pragma unroll
  for (int d0 = 0; d0 < DQK / 32; ++d0) {
    p0 = __builtin_amdgcn_mfma_f32_32x32x16_bf16(kf[2 * d0], qr[d0], p0, 0, 0, 0);
    p1 = __builtin_amdgcn_mfma_f32_32x32x16_bf16(kf[2 * d0 + 1], qr[d0], p1, 0, 0, 0); }
#pragma unroll
  for (int d0 = DQK / 32; d0 < DQK / 16; ++d0) { const int cb = (d0 * 16 + hi * 8) * 2;
    bf16x8 b0 = *reinterpret_cast<const bf16x8*>(Ks + KSWZ(r32, cb));
    bf16x8 b1 = *reinterpret_cast<const bf16x8*>(Ks + KSWZ(32 + r32, cb));
    p0 = __builtin_amdgcn_mfma_f32_32x32x16_bf16(b0, qr[d0], p0, 0, 0, 0);
    p1 = __builtin_amdgcn_mfma_f32_32x32x16_bf16(b1, qr[d0], p1, 0, 0, 0); }
  if (!valid) {
#pragma unroll
    for (int r = 0; r < 16; ++r) { p0[r] = -INFINITY; p1[r] = -INFINITY; } }
}
template <int DQK>
__device__ __forceinline__ void kload(bf16x8* kf, const char* Ks, int r32, int hi) {
#pragma unroll
  for (int d0 = 0; d0 < DQK / 32; ++d0) { const int cb = (d0 * 16 + hi * 8) * 2;
    kf[2 * d0] = *reinterpret_cast<const bf16x8*>(Ks + KSWZ(r32, cb)); kf[2 * d0 + 1] = *reinterpret_cast<const bf16x8*>(Ks + KSWZ(32 + r32, cb)); }
#pragma unroll
  for (int i = 0; i < DQK / 16; ++i) asm volatile("" : "+v"(kf[i]));
}
__device__ __forceinline__ int v_st(int k, int c) { const int kk = (k & ~0xC) | ((k & 4) << 1) | ((k & 8) >> 1); return ((kk >> 3) * 4 + (c >> 5)) * 512 + ((kk & 7) * 32 + (c & 31)) * 2; }
__device__ __forceinline__ int v_rd_base(int lane) { return ((lane & 3) << 3) | (((lane >> 2) & 3) << 6) | (((lane >> 4) & 1) << 5) | (((lane >> 5) & 1) << 8); }
constexpr int v_rd_off(int d0, int ks, int half) { return d0 * 512 + ks * 4096 + half * 2048; }
template <int OFF> __device__ __forceinline__ s16x4 tr_read(int vb) {
  s16x4 r; asm volatile("ds_read_b64_tr_b16 %0, %1 offset:%2" : "=&v"(r) : "v"(vb), "i"(OFF) : "memory"); return r;
}
template <int D0> __device__ __forceinline__ void pv_one(f32x16& od, int vb, bf16x8 pa0, bf16x8 pa1, bf16x8 pa2, bf16x8 pa3) {
  const s16x4 l0 = tr_read<v_rd_off(D0, 0, 0)>(vb), h0 = tr_read<v_rd_off(D0, 0, 1)>(vb), l1 = tr_read<v_rd_off(D0, 1, 0)>(vb), h1 = tr_read<v_rd_off(D0, 1, 1)>(vb);
  const s16x4 l2 = tr_read<v_rd_off(D0, 2, 0)>(vb), h2 = tr_read<v_rd_off(D0, 2, 1)>(vb), l3 = tr_read<v_rd_off(D0, 3, 0)>(vb), h3 = tr_read<v_rd_off(D0, 3, 1)>(vb);
  asm volatile("s_waitcnt lgkmcnt(0)" ::: "memory"); SBAR();
#define PK(Lo, Hi) (bf16x8){Lo[0], Lo[1], Lo[2], Lo[3], Hi[0], Hi[1], Hi[2], Hi[3]}
  od = __builtin_amdgcn_mfma_f32_32x32x16_bf16(pa0, PK(l0, h0), od, 0, 0, 0);
  od = __builtin_amdgcn_mfma_f32_32x32x16_bf16(pa1, PK(l1, h1), od, 0, 0, 0);
  od = __builtin_amdgcn_mfma_f32_32x32x16_bf16(pa2, PK(l2, h2), od, 0, 0, 0);
  od = __builtin_amdgcn_mfma_f32_32x32x16_bf16(pa3, PK(l3, h3), od, 0, 0, 0);
#undef PK
}
__device__ __forceinline__ void pv_d0(f32x16* o, int vb, bf16x8 pa0, bf16x8 pa1, bf16x8 pa2, bf16x8 pa3) {
  pv_one<0>(o[0], vb, pa0, pa1, pa2, pa3); pv_one<1>(o[1], vb, pa0, pa1, pa2, pa3); pv_one<2>(o[2], vb, pa0, pa1, pa2, pa3); pv_one<3>(o[3], vb, pa0, pa1, pa2, pa3);
}

template <int DQK, bool MASKED, bool FIXM, int OUT>
__device__ __forceinline__ bool attn_unit(const bf16_t* __restrict__ Qb, const bf16_t* __restrict__ Kh, const bf16_t* __restrict__ Vh, bf16_t* __restrict__ Ob, const unsigned* __restrict__ mask, int ldq, int ldk, int q0, char* lds, float kmax2, const int w0, float lam = 0.f, float post = 0.f, const float* __restrict__ gain = nullptr) {
  constexpr int SHM_K = KVBLK * DQK * 2, ND0 = DQK / 16, NLD = DQK == 128 ? 4 : 3;
  int tid_ = tid_of(w0); asm volatile("" : "+v"(tid_));
  const int tid = tid_, wid = tid >> 6, lane = tid & 63, r32 = lane & 31, hi = lane >> 5;
  char* V_lds = lds; char* K_lds = lds + 3 * SHM_V;
  float* ws = (float*)(lds + 3 * SHM_V + 3 * SHM_K) + wid * 64; float* li_l = ws; float* al_l = ws + 32;
  float m_reg = -1e30f, l_reg = 0; f32x16 o[4] = {}; bf16x8 qr[ND0];
  const bf16_t* Qw = Qb + (long)(q0 + wid * QBLK + r32) * ldq + hi * 8;
  const unsigned* mrow = mask + (q0 + wid * QBLK + r32);
#pragma unroll
  for (int d0 = 0; d0 < ND0; ++d0) qr[d0] = *reinterpret_cast<const bf16x8*>(Qw + d0 * 16);
  float negb = 0.f;
  unsigned* badw = (unsigned*)(lds + 3 * SHM_V + 3 * SHM_K + NW * 256);
  if (FIXM) {
    if constexpr (!MASKED) {
      float qn2 = 0.f;
#pragma unroll
      for (int d0 = 0; d0 < ND0; ++d0)
#pragma unroll
        for (int e2 = 0; e2 < 8; ++e2) { const float v = bf2f((unsigned short)qr[d0][e2]); qn2 = __builtin_fmaf(v, v, qn2); }
      { auto rr = __builtin_amdgcn_permlane32_swap(__float_as_uint(qn2), __float_as_uint(qn2), false, false); qn2 = __uint_as_float(rr[0]) + __uint_as_float(rr[1]); }
      negb = -(sqrtf(qn2 * kmax2 * (DQK == 64 ? 2.0f : 4.0f)) * 1.02f + 1.0e-3f);
    }
    if (tid == 0) *badw = 0u;
  }
  const int sr = tid >> 4, sc = (tid & 15) * 8, vst0 = v_st(sr, sc), vst1 = v_st(32 + sr, sc);
  const int kr = DQK == 128 ? sr : (tid >> 3), kc = DQK == 128 ? sc : (tid & 7) * 8, kst = KSWZ(kr, kc * 2), kst1 = KSWZ(32 + kr, kc * 2);
  const int vb0 = (int)(uintptr_t)V_lds + v_rd_base(lane);
  struct { bf16x8 vs0, vs1, ks0, ks1; } sr_[2];
#define SLOAD(i, k0) do { sr_[i].vs0 = *reinterpret_cast<const bf16x8*>(&Vh[(long)((k0) + sr) * ldk + sc]); sr_[i].vs1 = *reinterpret_cast<const bf16x8*>(&Vh[(long)((k0) + 32 + sr) * ldk + sc]); \
    sr_[i].ks0 = *reinterpret_cast<const bf16x8*>(&Kh[(long)((k0) + kr) * ldk + kc]); if (DQK == 128) sr_[i].ks1 = *reinterpret_cast<const bf16x8*>(&Kh[(long)((k0) + 32 + kr) * ldk + kc]); } while (0)
#define SWRITE(s, i) do { *(bf16x8*)(V_lds + (s) * SHM_V + vst0) = sr_[i].vs0; *(bf16x8*)(V_lds + (s) * SHM_V + vst1) = sr_[i].vs1; \
    *(bf16x8*)(K_lds + (s) * SHM_K + kst) = sr_[i].ks0; if (DQK == 128) *(bf16x8*)(K_lds + (s) * SHM_K + kst1) = sr_[i].ks1; } while (0)
#define SWAIT() do { if (NLD == 4) asm volatile("s_waitcnt vmcnt(4)" ::: "memory"); else asm volatile("s_waitcnt vmcnt(3)" ::: "memory"); } while (0)
#define RESC(a) do { if (!FIXM && __any((a) < 1.f)) { if (hi == 0) al_l[r32] = (a); asm volatile("s_waitcnt lgkmcnt(0)" ::: "memory"); \
    _Pragma("unroll") for (int d = 0; d < 4; ++d) _Pragma("unroll") for (int r = 0; r < 16; ++r) o[d][r] *= al_l[crow(r, hi)]; } } while (0)
#define ROT() do { s_prev = s_cur; s_cur = s_next; s_next = (s_next == 2) ? 0 : s_next + 1; } while (0)
#define PSM(REL, P0, P1, MN, AL) do { if (FIXM) { AL = 1.f; _Pragma("unroll") for (int r_ = 0; r_ < 16; ++r_) P0[r_] = __builtin_amdgcn_exp2f(P0[r_]); } else partialSM<REL>(P0, P1, m_reg, MN, AL); } while (0)
  f32x16 pA0, pA1, pB0, pB1; float mnA, mnB, alA, alB; bf16x8 pa0, pa1, pa2, pa3;
  const int NT = (q0 >> 6) + 4, NTw = (q0 >> 6) + (w0 >> 1) + 1;
  if (w0 >= 4) __builtin_amdgcn_s_setprio(1);
  constexpr bool DMA = ((DQK == 64) && !MASKED && FIXM) || ((DQK == 128) && MASKED);
#define MW(t, a, b) do { if (MASKED) { a = mrow[(size_t)(2 * (t)) * L]; b = mrow[(size_t)(2 * (t) + 1) * L]; } } while (0)
  unsigned mw0 = 0u, mw1 = 0u;
  if constexpr (DMA) {
#define KOFF_(T_) (DQK == 64 ? (unsigned)((((T_) >> 3)) * ldk + ((((T_) & 7) ^ ((((T_) >> 3) >> 1) & 7)) * 8)) : (unsigned)(((T_) >> 4) * ldk + ((((T_) & 15) ^ (((T_) >> 4) & 15)) * 8)))
#define VKEY_(P_) (((((P_) >> 5) >> 2) * 8 + (((P_) >> 2) & 7)))
#define VOFF_(P_) ((unsigned)((((VKEY_(P_)) & ~0xC) | (((VKEY_(P_)) & 4) << 1) | (((VKEY_(P_)) & 8) >> 1)) * ldk + (((P_) >> 5) & 3) * 32 + ((P_) & 3) * 8))
    LAS unsigned char* Kd = (LAS unsigned char*)K_lds + w0 * 1024; LAS unsigned char* Vd = (LAS unsigned char*)V_lds + w0 * 1024;
    const unsigned kol_ = KOFF_(tid), vol_ = VOFF_(tid);
#define DMA_K(t_, slot_) do { int td_ = tid; asm volatile("" : "+v"(td_)); const unsigned ko_ = kol_; \
      __builtin_amdgcn_global_load_lds((const unsigned*)(Kh + (size_t)((t_) * KVBLK) * ldk + ko_), (LAS unsigned*)(Kd + (slot_) * SHM_K), 16, 0, 0); \
      if (DQK == 128) __builtin_amdgcn_global_load_lds((const unsigned*)(Kh + (size_t)((t_) * KVBLK + 32) * ldk + ko_), (LAS unsigned*)(Kd + (slot_) * SHM_K + 8192), 16, 0, 0); } while (0)
#define DMA_V(t_, slot_) do { int td_ = tid; asm volatile("" : "+v"(td_)); const unsigned vo_ = vol_;     \
                              __builtin_amdgcn_global_load_lds((const unsigned*)(Vh + (size_t)((t_) * KVBLK) * ldk + vo_), (LAS unsigned*)(Vd + (slot_) * SHM_V), 16, 0, 0); \
                              __builtin_amdgcn_global_load_lds((const unsigned*)(Vh + (size_t)((t_) * KVBLK + 32) * ldk + vo_), (LAS unsigned*)(Vd + (slot_) * SHM_V + 8192), 16, 0, 0); } while (0)
#define DBAR(n_) do { asm volatile("s_waitcnt vmcnt(" #n_ ") lgkmcnt(0)" ::: "memory"); __builtin_amdgcn_s_barrier(); asm volatile("" ::: "memory"); } while (0)
#define DBARS() do { if (DQK == 128) DBAR(4); else DBAR(3); } while (0)
    DMA_K(0, 0); DMA_V(0, 0); DMA_K(1, 1);
    DBAR(0);
    MW(0, mw0, mw1); qkt<DQK, MASKED, FIXM>(pA0, pA1, K_lds, qr, r32, hi, true, mw0, mw1, negb); PSM(false, pA0, pA1, mnA, alA); SBAR();
    DMA_K(2, 2); DMA_V(1, 1); SBAR();
    DBARS();
    int sk = 1, sv = 0;
#define S3(x) ((x) >= 3 ? (x) - 3 : (x))
#define DSTEP(PN0, PN1, PO0, PO1, MNN, ALN, ALO, T) do { \
      if ((T) < NTw) { MW(T, mw0, mw1); qkt<DQK, MASKED, FIXM>(PN0, PN1, K_lds + sk * SHM_K, qr, r32, hi, true, mw0, mw1, negb); } \
      if ((T) - 1 < NTw) finishSM(PO0, PO1, ALO, l_reg, pa0, pa1, pa2, pa3); SBAR(); \
      DMA_K(min((T) + 2, NT - 1), S3(sk + 2)); DMA_V((T) + 1, S3(sv + 2)); SBAR(); \
      if ((T) - 1 < NTw) pv_d0(o, vb0 + sv * SHM_V, pa0, pa1, pa2, pa3); if ((T) < NTw) PSM(!MASKED, PN0, PN1, MNN, ALN); else ALN = 1.f; \
      RESC(ALN); DBARS(); sk = S3(sk + 1); sv = S3(sv + 1); } while (0)
    for (int j = 1; j + 1 < NT; j += 2) {
      DSTEP(pB0, pB1, pA0, pA1, mnB, alB, alA, j);
      DSTEP(pA0, pA1, pB0, pB1, mnA, alA, alB, j + 1);
    }
#undef DSTEP
    MW(NT - 1, mw0, mw1); qkt<DQK, MASKED, FIXM>(pB0, pB1, K_lds + sk * SHM_K, qr, r32, hi, NT - 1 < NTw, mw0, mw1, negb); if (NT - 2 < NTw) finishSM(pA0, pA1, alA, l_reg, pa0, pa1, pa2, pa3); SBAR();
    if (NT - 2 < NTw) pv_d0(o, vb0 + sv * SHM_V, pa0, pa1, pa2, pa3); PSM(!MASKED, pB0, pB1, mnB, alB);
    RESC(alB);
    DBAR(0);
    finishSM(pB0, pB1, alB, l_reg, pa0, pa1, pa2, pa3); SBAR();
    if (NT - 1 < NTw) pv_d0(o, vb0 + S3(sv + 1) * SHM_V, pa0, pa1, pa2, pa3);
#undef S3
#undef KOFF_
#undef VKEY_
#undef VOFF_
#undef DMA_K
#undef DMA_V
#undef DBAR
#undef DBARS
  } else {
  constexpr int SE = 0, SO = 1;
  int s_prev = 0, s_cur = 0, s_next = 1;
  SLOAD(SE, 0); asm volatile("s_waitcnt vmcnt(0)" ::: "memory"); SWRITE(0, SE); __syncthreads();
  MW(0, mw0, mw1);
  qkt<DQK, MASKED, FIXM>(pA0, pA1, K_lds, qr, r32, hi, true, mw0, mw1, negb); PSM(false, pA0, pA1, mnA, alA);
  SLOAD(SO, KVBLK); SLOAD(SE, 2 * KVBLK);
  SWAIT(); SWRITE(1, SO); __syncthreads();
  ROT();
  for (int j = 1; j + 1 < NT; j += 2) {
    MW(j, mw0, mw1); SBAR(); qkt<DQK, MASKED, FIXM>(pB0, pB1, K_lds + s_cur * SHM_K, qr, r32, hi, j < NTw, mw0, mw1, negb);
    finishSM(pA0, pA1, alA, l_reg, pa0, pa1, pa2, pa3); SBAR();
    SLOAD(SO, (j + 2) * KVBLK); SBAR();
    if (j - 1 < NTw) pv_d0(o, vb0 + s_prev * SHM_V, pa0, pa1, pa2, pa3); PSM(!MASKED, pB0, pB1, mnB, alB);
    SWAIT(); SWRITE(s_next, SE);
    RESC(alB); __syncthreads(); ROT();
    MW(j + 1, mw0, mw1); SBAR(); qkt<DQK, MASKED, FIXM>(pA0, pA1, K_lds + s_cur * SHM_K, qr, r32, hi, j + 1 < NTw, mw0, mw1, negb);
    finishSM(pB0, pB1, alB, l_reg, pa0, pa1, pa2, pa3); SBAR();
    if (j + 3 < NT) SLOAD(SE, (j + 3) * KVBLK); SBAR();
    if (j < NTw) pv_d0(o, vb0 + s_prev * SHM_V, pa0, pa1, pa2, pa3); PSM(!MASKED, pA0, pA1, mnA, alA);
    SWAIT(); SWRITE(s_next, SO);
    RESC(alA); __syncthreads(); ROT();
  }
  MW(NT - 1, mw0, mw1); SBAR(); qkt<DQK, MASKED, FIXM>(pB0, pB1, K_lds + s_cur * SHM_K, qr, r32, hi, NT - 1 < NTw, mw0, mw1, negb);
  finishSM(pA0, pA1, alA, l_reg, pa0, pa1, pa2, pa3); SBAR();
  if (NT - 2 < NTw) pv_d0(o, vb0 + s_prev * SHM_V, pa0, pa1, pa2, pa3); PSM(!MASKED, pB0, pB1, mnB, alB);
  RESC(alB);
  finishSM(pB0, pB1, alB, l_reg, pa0, pa1, pa2, pa3); SBAR();
  if (NT - 1 < NTw) pv_d0(o, vb0 + s_cur * SHM_V, pa0, pa1, pa2, pa3);
  }
  if (hi == 0) li_l[r32] = l_reg; asm volatile("s_waitcnt lgkmcnt(0)" ::: "memory");
  float rli[16];
#pragma unroll
  for (int r = 0; r < 16; ++r) rli[r] = __builtin_amdgcn_rcpf(li_l[crow(r, hi)]);
  bf16_t* Ow = Ob + (long)(q0 + wid * QBLK) * LDO;
  unsigned* stash = (unsigned*)(lds + STASH_OFF);
#define OUT_TILE(EXPR) do { __syncthreads(); bf16_t* ot_ = (bf16_t*)(lds + wid * 8192); \
    _Pragma("unroll") for (int r = 0; r < 16; ++r) { const int orow = crow(r, hi); \
      _Pragma("unroll") for (int d0 = 0; d0 < 4; ++d0) ot_[orow * 128 + d0 * 32 + r32] = (bf16_t)(cvt_pk_bf16((EXPR), 0.f) & 0xffffu); } \
    asm volatile("s_waitcnt lgkmcnt(0)" ::: "memory"); \
    _Pragma("unroll") for (int i = 0; i < 8; ++i) { const int row_ = i * 4 + (lane >> 4), ch_ = lane & 15; \
      *(u32x4*)(Ow + (long)row_ * LDO + ch_ * 8) = *(const u32x4*)(ot_ + row_ * 128 + ch_ * 8); } } while (0)
  if (OUT == 0) {
    OUT_TILE(o[d0][r] * rli[r]);
  } else if (OUT == 1) {
#pragma unroll
    for (int d0 = 0; d0 < 4; ++d0)
#pragma unroll
      for (int rr = 0; rr < 8; ++rr) stash[(d0 * 8 + rr) * 512 + tid] = cvt_pk_bf16(o[d0][2 * rr] * rli[2 * rr], o[d0][2 * rr + 1] * rli[2 * rr + 1]);
  } else {
    float ss[16];
#pragma unroll
    for (int r = 0; r < 16; ++r) ss[r] = 0.f;
#pragma unroll
    for (int d0 = 0; d0 < 4; ++d0)
#pragma unroll
      for (int rr = 0; rr < 8; ++rr) { const unsigned w = stash[(d0 * 8 + rr) * 512 + tid];
        const float da = bflo(w) - lam * (o[d0][2 * rr] * rli[2 * rr]), db = bfhi(w) - lam * (o[d0][2 * rr + 1] * rli[2 * rr + 1]);
        o[d0][2 * rr] = da; o[d0][2 * rr + 1] = db; ss[2 * rr] = __builtin_fmaf(da, da, ss[2 * rr]); ss[2 * rr + 1] = __builtin_fmaf(db, db, ss[2 * rr + 1]); }
#pragma unroll
    for (int r = 0; r < 16; ++r) {
      {
#define SWZ_(m) ss[r] += __int_as_float(__builtin_amdgcn_ds_swizzle(__float_as_int(ss[r]), ((m) << 10) | 0x1f))
        SWZ_(1); SWZ_(2); SWZ_(4); SWZ_(8); SWZ_(16);
#undef SWZ_
      }
      ss[r] = post * __builtin_amdgcn_rsqf(ss[r] * (1.0f / 128.0f) + EPS); }
    float gn[4];
#pragma unroll
    for (int d0 = 0; d0 < 4; ++d0) gn[d0] = gain[d0 * 32 + r32];
    OUT_TILE(o[d0][r] * ss[r] * gn[d0]);
  }
#undef OUT_TILE
  if (FIXM && __any(!(l_reg > 7.0e-31f) || !(l_reg < 1.0e30f))) { if (lane == 0) *badw = 1u; }
  if (w0 >= 4) __builtin_amdgcn_s_setprio(0);
  __syncthreads();
  bool bad = false; if (FIXM) { bad = *badw != 0u; __syncthreads(); }
#undef PSM
#undef MW
#undef ROT
#undef SLOAD
#undef SWRITE
#undef SWAIT
#undef RESC
  return bad;
}
#undef SBAR
}

namespace dsa {
__device__ __forceinline__ unsigned mono(float s) { const unsigned b = __float_as_uint(s); return b ^ ((unsigned)((int)b >> 31) | 0x80000000u); }
__device__ __forceinline__ float relu_i(float s) { const int b = __float_as_int(s); return __int_as_float(b > 0 ? b : 0); }
__device__ __forceinline__ float fmac1(float a, float b, float acc) { asm("v_fmac_f32_e32 %0, %1, %2" : "+v"(acc) : "v"(a), "v"(b)); return acc; }
__device__ __forceinline__ void load_group(bf16x8 (&k)[4], const bf16_t* __restrict__ KI, int key0, int qi, int g) {
  const bf16_t* kp = KI + (size_t)(key0 + qi) * 64 + g * 8;
  k[0] = *reinterpret_cast<const bf16x8*>(kp); k[1] = *reinterpret_cast<const bf16x8*>(kp + 32);
  k[2] = *reinterpret_cast<const bf16x8*>(kp + 16 * 64); k[3] = *reinterpret_cast<const bf16x8*>(kp + 16 * 64 + 32);
}
__device__ __forceinline__ void score_group(f32x4& ta, f32x4& tb, const bf16x8 (&k)[4], const bf16x8 (&qf)[8][2], const float (&wq)[8]) {
  ta = (f32x4){0.f, 0.f, 0.f, 0.f}; tb = (f32x4){0.f, 0.f, 0.f, 0.f};
#pragma unroll
  for (int h = 0; h < 8; ++h) {
    f32x4 sa = (f32x4){0.f, 0.f, 0.f, 0.f}, sb = (f32x4){0.f, 0.f, 0.f, 0.f};
    sa = __builtin_amdgcn_mfma_f32_16x16x32_bf16(k[0], qf[h][0], sa, 0, 0, 0); sb = __builtin_amdgcn_mfma_f32_16x16x32_bf16(k[2], qf[h][0], sb, 0, 0, 0);
    sa = __builtin_amdgcn_mfma_f32_16x16x32_bf16(k[1], qf[h][1], sa, 0, 0, 0); sb = __builtin_amdgcn_mfma_f32_16x16x32_bf16(k[3], qf[h][1], sb, 0, 0, 0);
#pragma unroll
    for (int r = 0; r < 4; ++r) { ta[r] = fmac1(wq[h], relu_i(sa[r]), ta[r]); tb[r] = fmac1(wq[h], relu_i(sb[r]), tb[r]); }
  }
}
template <bool RAW>
__device__ __forceinline__ unsigned hist_find(const LAS unsigned* hq, unsigned need, unsigned& above, int lane) {
  unsigned wv[16]; unsigned ls = 0u;
  if (RAW) {
    const bool ng = lane >= 32; unsigned rv[16];
#pragma unroll
    for (int i = 0; i < 4; ++i) { const u32x4 v = *(const LAS u32x4*)(hq + (ng ? 16 * lane : 512 - 16 * (lane + 1)) + 4 * i); rv[4 * i] = v.x; rv[4 * i + 1] = v.y; rv[4 * i + 2] = v.z; rv[4 * i + 3] = v.w; }
#pragma unroll
    for (int i = 0; i < 16; ++i) { const unsigned x = rv[15 - i]; wv[i] = ng ? ((x >> 16) | (x << 16)) : rv[i]; }
  } else {
#pragma unroll
  for (int i = 0; i < 4; ++i) { const u32x4 v = *(const LAS u32x4*)(hq + 1024 - 16 * (lane + 1) + 4 * i); wv[4 * i] = v.x; wv[4 * i + 1] = v.y; wv[4 * i + 2] = v.z; wv[4 * i + 3] = v.w; }
  }
#pragma unroll
  for (int i = 0; i < 16; ++i) ls += (wv[i] & 0xffffu) + (wv[i] >> 16);
  unsigned inc = ls;
#define DPPADD_(ctrl_, rmask_) inc += (unsigned)__builtin_amdgcn_update_dpp(0, (int)inc, ctrl_, rmask_, 0xf, false)
  DPPADD_(0x111, 0xf); DPPADD_(0x112, 0xf); DPPADD_(0x114, 0xf); DPPADD_(0x118, 0xf); DPPADD_(0x142, 0xa); DPPADD_(0x143, 0xc);
#undef DPPADD_
  const unsigned long long bal = __ballot(inc >= need);
  const int ls_ = bal ? (__ffsll((long long)bal) - 1) : 63;
  const int lsu_ = __builtin_amdgcn_readfirstlane(ls_);
  unsigned cum = (unsigned)__builtin_amdgcn_readlane((int)(inc - ls), lsu_);
  unsigned bin = 0u, ab = 0u; bool found = false;
#pragma unroll
  for (int i = 15; i >= 0; --i) {
    const unsigned chi = wv[i] >> 16, clo = wv[i] & 0xffffu;
    if (!found && cum + chi >= need) { found = true; bin = 2 * i + 1; ab = cum; } cum += found ? 0u : chi;
    if (!found && cum + clo >= need) { found = true; bin = 2 * i; ab = cum; } cum += found ? 0u : clo;
  }
  bin += (unsigned)(1024 - 16 * (lane + 1)) * 2u;
  above = (unsigned)__builtin_amdgcn_readlane((int)ab, lsu_);
  return (unsigned)__builtin_amdgcn_readlane((int)bin, lsu_);
}
constexpr int CAND_CAP = 1024;
__device__ __forceinline__ void select_block(int q0, const bf16_t* __restrict__ QI, const bf16_t* __restrict__ KI, const float* __restrict__ WI, unsigned* __restrict__ MASK, LAS unsigned char* lds, const int w0) {
  int tid_ = tid_of(w0); asm volatile("" : "+v"(tid_));
  const int tid = tid_, lane = tid & 63, wave = __builtin_amdgcn_readfirstlane(tid >> 6), qi = lane & 15, g = lane >> 4;
  const int n = ((q0 >> 6) + 1) << 6, NT = n >> 5;
  LAS unsigned* hist = (LAS unsigned*)lds;
  LAS unsigned* cand = (LAS unsigned*)(lds + 65536);
  LAS unsigned* tb = (LAS unsigned*)(lds + 131072);
  if (n <= 256) {
    for (int t = wave; t < NT; t += 8) if (g == 0) MASK[(size_t)t * L + q0 + qi] = 0xffffffffu;
    return;
  }
  bf16x8 qf[8][2]; float wq[8];
  { const bf16_t* qp = QI + (size_t)(q0 + qi) * 512 + g * 8;
#pragma unroll
    for (int h = 0; h < 8; ++h) { qf[h][0] = *reinterpret_cast<const bf16x8*>(qp + h * 64); qf[h][1] = *reinterpret_cast<const bf16x8*>(qp + h * 64 + 32); wq[h] = WI[(size_t)(q0 + qi) * 8 + h]; } }
  f32x4 ta, tb4; bf16x8 kc[4], kn[4];
  LAS unsigned char* hq = (LAS unsigned char*)(hist + qi * 1024);
  unsigned* mq = MASK + q0 + qi;
  __syncthreads();
#pragma unroll
  for (int i = 0; i < 8; ++i) *(LAS u32x4*)(hist + (size_t)(i * 512 + tid) * 4) = (u32x4){0u, 0u, 0u, 0u};
  if (tid < 17) tb[48 + tid] = 0u;
  __syncthreads();
#define HISTA() do { _Pragma("unroll") for (int r = 0; r < 8; ++r) {     \
      const unsigned b = __float_as_uint(r < 4 ? ta[r & 3] : tb4[r & 3]); unsigned wd, inc; \
      asm("v_lshrrev_b32 %0, 22, %1" : "=v"(wd) : "v"(b)); \
      asm("v_mad_u32_u24 %0, %1, %2, 1" : "=v"(inc) : "v"((b >> 21) & 1u), "s"(0xffffu)); \
      __hip_atomic_fetch_add((LAS unsigned*)(hq + (wd << 2)), inc, __ATOMIC_RELAXED, __HIP_MEMORY_SCOPE_WORKGROUP); } } while (0)
  load_group(kc, KI, wave * 32, qi, g);
#pragma unroll 1
  for (int t = wave; t < NT; t += 16) {
    load_group(kn, KI, min(t + 8, NT - 1) * 32, qi, g);
    score_group(ta, tb4, kc, qf, wq);
    HISTA();
    load_group(kc, KI, min(t + 16, NT - 1) * 32, qi, g);
    if (t + 8 < NT) { score_group(ta, tb4, kn, qf, wq); HISTA(); }
  }
#undef HISTA
  __syncthreads();
#pragma unroll 1
  for (int qq = 0; qq < 2; ++qq) {
    const int q = wave * 2 + qq; unsigned above;
    const unsigned bin = hist_find<true>(hist + q * 1024, 256u, above, lane);
    if (lane == 0) { tb[q] = bin; tb[16 + q] = 256u - above; }
  }
  __syncthreads();
#pragma unroll
  for (int i = 0; i < 8; ++i) *(LAS u32x4*)(hist + (size_t)(i * 512 + tid) * 4) = (u32x4){0u, 0u, 0u, 0u};
  __syncthreads();
  const unsigned bs = tb[qi];
  const float flo = __uint_as_float(bs >= 1024u ? (bs - 1024u) << 21 : ((2047u - bs) << 21) | 0x1fffffu);
  const float fhi = bs >= 2043u ? INFINITY : __uint_as_float(bs + 1u >= 1024u ? (bs + 1u - 1024u) << 21 : ((2046u - bs) << 21) | 0x1fffffu);
  LAS unsigned* cq = cand + qi * CAND_CAP;
#define CLASSB(T_) do { unsigned w = 0u; \
      _Pragma("unroll") for (int r = 0; r < 8; ++r) { \
        const float sc = r < 4 ? ta[r & 3] : tb4[r & 3]; const bool def = sc >= fhi; \
        const int pos = (r < 4 ? r : 12 + r) + 4 * g;                                    \
        w |= (def ? 1u : 0u) << (r < 4 ? r : 12 + r); \
        if (sc >= flo && !def) {                                                          \
          const unsigned key = mono(sc); \
          __hip_atomic_fetch_add((LAS unsigned*)(hq + ((key >> 9) & 0xffcu)), 1u << ((key >> 6) & 16u), __ATOMIC_RELAXED, __HIP_MEMORY_SCOPE_WORKGROUP); \
          const unsigned ix = __hip_atomic_fetch_add(tb + 48 + qi, 1u, __ATOMIC_RELAXED, __HIP_MEMORY_SCOPE_WORKGROUP); \
          if (ix < (unsigned)CAND_CAP) cq[ix] = ((unsigned)((T_) * 32 + pos) << 11) | ((key >> 10) & 2047u); else tb[64] = 1u; \
        } } \
      w <<= 4 * g; { auto s1_ = __builtin_amdgcn_permlane16_swap(w, w, false, false); w = s1_[0] | s1_[1]; auto s2_ = __builtin_amdgcn_permlane32_swap(w, w, false, false); w = s2_[0] | s2_[1]; }     \
      if (g == 0) mq[(size_t)(T_) * L] = w; } while (0)
  load_group(kc, KI, wave * 32, qi, g);
#pragma unroll 1
  for (int t = wave; t < NT; t += 16) {
    load_group(kn, KI, min(t + 8, NT - 1) * 32, qi, g);
    score_group(ta, tb4, kc, qf, wq);
    CLASSB(t);
    load_group(kc, KI, min(t + 16, NT - 1) * 32, qi, g);
    if (t + 8 < NT) { score_group(ta, tb4, kn, qf, wq); CLASSB(t + 8); }
  }
#undef CLASSB
  asm volatile("s_waitcnt vmcnt(0)" ::: "memory");
  __syncthreads();
#pragma unroll 1
  for (int qq = 0; qq < 2; ++qq) {
    const int q = wave * 2 + qq; unsigned above;
    const unsigned bin = hist_find<false>(hist + q * 1024, tb[16 + q], above, lane);
    if (lane == 0) tb[32 + q] = (tb[q] << 11) | bin;
  }
  __syncthreads();
  if (tb[64] == 0u) {
#pragma unroll 1
    for (int qq = 0; qq < 2; ++qq) {
      const int q = wave * 2 + qq; const unsigned b2 = tb[32 + q] & 2047u; const int cnt = (int)tb[48 + q];
      for (int i = lane; i < cnt; i += 64) { const unsigned c = cand[q * CAND_CAP + i];
        if ((c & 2047u) >= b2) { const unsigned kidx = c >> 11; atomicOr(MASK + (size_t)(kidx >> 5) * L + q0 + q, 1u << (kidx & 31u)); } }
    }
  } else {
    const unsigned T22 = tb[32 + qi];
    load_group(kc, KI, wave * 32, qi, g);
#pragma unroll 1
    for (int t = wave; t < NT; t += 8) {
      if (t + 8 < NT) load_group(kn, KI, (t + 8) * 32, qi, g);
      score_group(ta, tb4, kc, qf, wq);
#pragma unroll
      for (int i = 0; i < 4; ++i) kc[i] = kn[i];
      unsigned w = 0u;
#pragma unroll
      for (int r = 0; r < 4; ++r) { w |= ((mono(ta[r]) >> 10) >= T22 ? 1u : 0u) << r; w |= ((mono(tb4[r]) >> 10) >= T22 ? 1u : 0u) << (16 + r); }
      w <<= 4 * g; { auto s1_ = __builtin_amdgcn_permlane16_swap(w, w, false, false); w = s1_[0] | s1_[1]; auto s2_ = __builtin_amdgcn_permlane32_swap(w, w, false, false); w = s2_[0] | s2_[1]; }
      if (g == 0) mq[(size_t)t * L] = w;
    }
  }
  __syncthreads();
}
}

constexpr size_t MiB = 1u << 20;
constexpr size_t WS_CTL = 0, WS_SSQ = 1 * MiB, ZERO_BYTES = 2 * MiB;
constexpr size_t WS_MISC = 2 * MiB;
constexpr size_t WS_ROPE128 = 3 * MiB, WS_ROPE64 = 11 * MiB;
constexpr size_t WS_LBP = 15 * MiB, WS_BBT = 16 * MiB + 512 * 1024;
constexpr size_t WS_S5MF = 18 * MiB, WS_S5E = 42 * MiB;
constexpr size_t WS_KMEM = 58 * MiB, WS_VMEMT = 62 * MiB, WS_MEMB = 66 * MiB, WS_WGLU = 67 * MiB;
constexpr size_t WS_WIN = 70 * MiB, WS_WOUT = 162 * MiB, WS_WQ = 194 * MiB, WS_WK = 226 * MiB, WS_WV = 258 * MiB, WS_WO = 290 * MiB, WS_WFF1 = 322 * MiB, WS_WFF2 = 450 * MiB;
constexpr size_t WS_XSA = WS_WK, WS_XOB = WS_WV;
constexpr size_t WS_XB = 578 * MiB;
constexpr size_t WS_ACT = 642 * MiB;
constexpr size_t WS_QA = WS_ACT, WS_KA = WS_ACT + 16 * MiB, WS_VA = WS_ACT + 32 * MiB, WS_QI = WS_ACT + 48 * MiB, WS_KI = WS_ACT + 64 * MiB, WS_WI = WS_ACT + 66 * MiB;
constexpr size_t WS_S5A = WS_ACT + 67 * MiB, WS_S5EO = WS_ACT + 91 * MiB, WS_YB = WS_ACT + 107 * MiB;
constexpr size_t WS_QC = WS_ACT + 123 * MiB, WS_KC = WS_ACT + 155 * MiB, WS_VC = WS_ACT + 187 * MiB, WS_OD = WS_ACT + 219 * MiB, WS_CAT = WS_ACT + 283 * MiB;
constexpr size_t WS_QX = WS_ACT, WS_PX = WS_ACT + 64 * MiB, WS_OX = WS_ACT + 96 * MiB;
constexpr size_t WS_HID = WS_ACT;
constexpr size_t WS_SSQP = WS_ACT + 347 * MiB;
constexpr size_t WS_MASK = WS_SSQP + 26 * MiB;
constexpr size_t WS_END = WS_MASK + 32 * MiB;
static_assert(WS_HID + (size_t)L * DFF * 2 <= WS_SSQP && WS_CAT + (size_t)L * DM * 2 <= WS_SSQP && WS_OX + (size_t)L * DM * 2 <= WS_CAT, "d_ws map");
constexpr int CW_BAR = 4096, CW_Q = 8192, CW_KMAX = 12288;

constexpr int RING_BYTES = 131072, EPI_OFF = 131072, LDS_BYTES = 147456, LDSCTL_OFF = LDS_BYTES - 1024, MISC_OFF = LDSCTL_OFF + 320;

typedef GAS unsigned gu32;
#define RLX_AGENT __ATOMIC_RELAXED, __HIP_MEMORY_SCOPE_AGENT
#define LDS_WAIT() asm volatile("s_waitcnt lgkmcnt(0)" ::: "memory")
#define VM_WAIT() asm volatile("s_waitcnt vmcnt(0)" ::: "memory")
#define XB_TMO      128
#define XB_XCNT(j)  (256  + 64 * (j))
#define XB_XSUB(j)  (1280 + 64 * (j))
#define XB_XGEN(j)  (2304 + 64 * (j))
#define XB_TOP      3328
#define XB_TOPGEN   3392
#define XCD_BAR_WORDS 3456
#define XB_SPIN_CAP (1u << 23)
__device__ __forceinline__ unsigned xb_ld(unsigned* p)              { return __hip_atomic_load(p, __ATOMIC_RELAXED, __HIP_MEMORY_SCOPE_AGENT); }
__device__ __forceinline__ unsigned xb_add(unsigned* p, unsigned v) { return __hip_atomic_fetch_add(p, v, __ATOMIC_RELAXED, __HIP_MEMORY_SCOPE_AGENT); }
__device__ __forceinline__ unsigned xb_xcc_id() { return (unsigned)__builtin_amdgcn_s_getreg((3 << 11) | 20) & 0xFu; }
#define XB_SPIN(cond, bar) do { unsigned _sp = 0; while (cond) { __builtin_amdgcn_s_sleep(1); \
    if ((++_sp & 255u) == 0u) { if (xb_ld(&(bar)[XB_TMO])) break; if (_sp > XB_SPIN_CAP) { atomicAdd(&(bar)[XB_TMO], 1u); break; } } } } while (0)
struct XcdBarrier { unsigned* bar; unsigned x; volatile LAS unsigned* st; };
__device__ __forceinline__ XcdBarrier xcd_barrier_post(unsigned* bar, volatile LAS unsigned* st) {
    XcdBarrier b; b.bar = bar; b.x = xb_xcc_id(); b.st = st;
    if (threadIdx.x == 0) (void)xb_add(&bar[XB_XCNT(b.x)], 1u);
    return b;
}
__device__ __forceinline__ void xcd_barrier_complete(unsigned* bar, unsigned x, unsigned& nloc, unsigned& nx) {
    const unsigned G = gridDim.x * gridDim.y * gridDim.z;
    unsigned sum, cnt, mine, sp = 0u;
    for (;;) {
        sum = 0u; cnt = 0u; mine = 0u;
#pragma unroll
        for (unsigned j = 0; j < 16; ++j) { const unsigned c = xb_ld(&bar[XB_XCNT(j)]); sum += c; cnt += (c > 0u) ? 1u : 0u; mine = (j == x) ? c : mine; }
        if (sum == G) break;
        __builtin_amdgcn_s_sleep(1);
        if ((++sp & 255u) == 0u) { if (xb_ld(&bar[XB_TMO])) break; if (sp > XB_SPIN_CAP) { atomicAdd(&bar[XB_TMO], 1u); break; } }
    }
    nloc = mine > 0u ? mine : 1u; nx = cnt > 0u ? cnt : 1u;
}
__device__ __forceinline__ void xcd_barrier(const XcdBarrier& b, const int w0) {
    asm volatile("s_waitcnt vmcnt(0)" ::: "memory");
    __syncthreads();
    int t0_ = tid_of(w0); asm volatile("" : "+v"(t0_));
    if (t0_ == 0) {
        unsigned* bar = b.bar;
        __builtin_amdgcn_s_waitcnt(0);
        unsigned nloc = b.st[0], nx = b.st[1];
        if (nloc == 0u) { xcd_barrier_complete(bar, b.x, nloc, nx); b.st[0] = nloc; b.st[1] = nx; }
        const unsigned old = xb_add(&bar[XB_XSUB(b.x)], 1u);
        const unsigned gen = old / nloc;
        if (old + 1u == (gen + 1u) * nloc) {
            __builtin_amdgcn_fence(__ATOMIC_RELEASE, "agent");
            asm volatile("s_waitcnt vmcnt(0)" ::: "memory");
            const unsigned og = xb_add(&bar[XB_TOP], 1u);
            const unsigned tg = og / nx;
            if (og + 1u == (tg + 1u) * nx) xb_add(&bar[XB_TOPGEN], 1u);
            else XB_SPIN(xb_ld(&bar[XB_TOPGEN]) == tg, bar);
            __builtin_amdgcn_fence(__ATOMIC_ACQUIRE, "agent");
            xb_add(&bar[XB_XGEN(b.x)], 1u);
            asm volatile("s_waitcnt vmcnt(0)" ::: "memory");
        } else {
            XB_SPIN(xb_ld(&bar[XB_XGEN(b.x)]) == gen, bar);
            __builtin_amdgcn_fence(__ATOMIC_ACQUIRE, "agent");
            asm volatile("s_waitcnt vmcnt(0)" ::: "memory");
        }
    }
    __syncthreads();
}

__device__ __forceinline__ float wave_sum(float v) {
#pragma unroll
    for (int o = 1; o < 64; o <<= 1) v += __shfl_xor(v, o);
    return v;
}
__device__ __forceinline__ float wave_max(float v) {
#pragma unroll
    for (int o = 1; o < 64; o <<= 1) v = fmaxf(v, __shfl_xor(v, o));
    return v;
}
__device__ __forceinline__ void cs_reduced(double a, float& c, float& s) {
    const double k = rint(a * 0.15915494309189535);
    const double r = (a - k * 6.283185307179586) - k * 2.4492935982947064e-16;
    const float rf = (float)r; c = cosf(rf); s = sinf(rf);
}

__device__ __forceinline__ int perm_pair(int d, int half) { return d < half ? 2 * d : 2 * (d - half) + 1; }
__device__ __forceinline__ void inproj_map(int n, int& row, float& cs) {
    cs = 1.0f;
    if (n < 512) { row = (n & ~127) + perm_pair(n & 127, 64); cs = SCL_A; }
    else if (n < 1024) { const int m = n - 512; row = 512 + (m & ~127) + perm_pair(m & 127, 64); }
    else if (n < 1536) { row = n; }
    else if (n < 2048) { const int m = n - 1536; row = 1536 + (m & ~63) + perm_pair(m & 63, 32); }
    else if (n < 2112) { row = 2048 + perm_pair(n - 2048, 32); }
    else if (n < 2120) { row = n; }
    else if (n < 2632) { row = 2304 + (n - 2120); }
    else if (n < 3656) { const int m = n - 2632; row = 2816 + (m & ~63) + perm_pair(m & 63, 32); cs = SCL_C; }
    else if (n < 4680) { const int m = n - 3656; row = 3840 + (m & ~63) + perm_pair(m & 63, 32); }
    else { row = 4864 + (n - 4680); }
}
__device__ __forceinline__ void transpose_item(const float* __restrict__ W, int K, int N, bf16_t* __restrict__ WT, const float* __restrict__ gain, int kind, LAS float* scr, int kb, int nb, int lane) {
    const int k0 = 64 * kb, n0 = 64 * nb;
    {
        const int c4 = (lane & 15) * 4, n = n0 + c4; f32x4 v[16];
#pragma unroll
        for (int i = 0; i < 16; ++i) { const int kk = 4 * i + (lane >> 4); v[i] = (n < N) ? *(const f32x4*)(W + (size_t)(k0 + kk) * N + n) : (f32x4){0.f, 0.f, 0.f, 0.f}; }
#pragma unroll
        for (int i = 0; i < 16; ++i) { const int kk = 4 * i + (lane >> 4); const float g = gain ? gain[k0 + kk] : 1.0f; LAS float* d = scr + kk * 65 + c4;
            d[0] = v[i][0] * g; d[1] = v[i][1] * g; d[2] = v[i][2] * g; d[3] = v[i][3] * g; }
    }
    LDS_WAIT(); asm volatile("" ::: "memory");
    const int c = lane & 7;
#pragma unroll
    for (int jj = 0; jj < 8; ++jj) {
        const int nn = (lane >> 3) + 8 * jj, n = n0 + nn;
        if (n < N) {
            int row = n; float cs = 1.0f;
            if (kind == 1) inproj_map(n, row, cs); else if (kind == 2) cs = SCL_X;
            const LAS float* s = scr + (8 * c) * 65 + nn;
            u32x4 o; o.x = cvt_pk_bf16(s[0 * 65] * cs, s[1 * 65] * cs); o.y = cvt_pk_bf16(s[2 * 65] * cs, s[3 * 65] * cs); o.z = cvt_pk_bf16(s[4 * 65] * cs, s[5 * 65] * cs); o.w = cvt_pk_bf16(s[6 * 65] * cs, s[7 * 65] * cs);
            *(u32x4*)(WT + (size_t)row * K + k0 + 8 * c) = o;
        }
    }
    LDS_WAIT(); asm volatile("" ::: "memory");
}

struct Args { const float* in[30]; float* out; unsigned char* ws; int ph_lo, ph_hi; };
constexpr int NWAVES = 8, NSTEP_PRO = 3, NSTEP_LAYER = 8, NSTEPS = NSTEP_PRO + DEPTH * NSTEP_LAYER + 1;

__global__ void __launch_bounds__(NWAVES * 64, 2) fwd_kernel(Args args) {
    extern __shared__ __attribute__((aligned(16))) unsigned char lds_raw[];
    LAS unsigned char* lds = (LAS unsigned char*)lds_raw;
    volatile LAS unsigned* MISC = (volatile LAS unsigned*)(lds + MISC_OFF);
    const int tid = threadIdx.x, lane = tid & 63, wave = __builtin_amdgcn_readfirstlane(tid >> 6);
    const int wave0 = wave;
#define W0() ({ int w_ = wave0; asm volatile("" : "+s"(w_)); w_; })
    const int G = gridDim.x; const int bx = blockIdx.x; const int vcu = (G % 8 == 0) ? (bx % 8) * (G / 8) + bx / 8 : bx;
    const int gw = vcu * NWAVES + wave, NGW = G * NWAVES;
    unsigned* ctl = (unsigned*)(args.ws + WS_CTL);
    for (int u = tid; u < (LDS_BYTES - LDSCTL_OFF) / 4; u += NWAVES * 64) ((LAS unsigned*)(lds + LDSCTL_OFF))[u] = 0u;
    __syncthreads();
    const int lo = args.ph_lo, hi = args.ph_hi;
    XcdBarrier bar; bar.bar = ctl + CW_BAR; bar.x = 0; bar.st = nullptr;
    if (hi - lo > 1) bar = xcd_barrier_post(ctl + CW_BAR, MISC + 8);
#ifndef SITE_MASK
#define SITE_MASK 0xFFFFu
#endif
#define SITE(id) (((SITE_MASK) >> (id)) & 1u)
#ifndef REP_MASK
#define REP_MASK 0u
#endif
#ifndef REP_N
#define REP_N 2
#endif
#define REPS(id) ((((REP_MASK) >> (id)) & 1u) ? (REP_N) : 1)
#define IN(k) (lo <= (k) && (k) < hi)
#define SEAM(k) do { if ((k) + 1 < hi) { XcdBarrier b_ = bar; asm volatile("" : "+s"(b_.bar)); xcd_barrier(b_, W0()); } } while (0)

    typedef __attribute__((address_space(4))) const Args CArgs;
    CArgs* const ap = (CArgs*)__builtin_amdgcn_kernarg_segment_ptr();
#define ENV() CArgs* ap_ = ap; asm volatile("" : "+s"(ap_)); unsigned char* const ws = ap_->ws; (void)ws
#define x_in (ap_->in[0])
#define mem (ap_->in[1])
#define norm_mix (ap_->in[2])
#define w_in (ap_->in[3])
#define s5_a_re (ap_->in[4])
#define s5_a_im (ap_->in[5])
#define s5_log_dt (ap_->in[6])
#define s5_b_re (ap_->in[7])
#define s5_b_im (ap_->in[8])
#define s5_c_re (ap_->in[9])
#define s5_c_im (ap_->in[10])
#define s5_d (ap_->in[11])
#define s5_w_glu (ap_->in[12])
#define s5_b_glu (ap_->in[13])
#define lam_q1 (ap_->in[14])
#define lam_k1 (ap_->in[15])
#define lam_q2 (ap_->in[16])
#define lam_k2 (ap_->in[17])
#define subln (ap_->in[18])
#define w_out (ap_->in[19])
#define norm_xattn (ap_->in[20])
#define norm_mem (ap_->in[21])
#define xq (ap_->in[22])
#define xk (ap_->in[23])
#define xv (ap_->in[24])
#define xo (ap_->in[25])
#define norm_mlp (ap_->in[26])
#define w_ff1 (ap_->in[27])
#define w_ff2 (ap_->in[28])
#define norm_final (ap_->in[29])
#define xres (ap_->out)
#define SSQ ((float*)(ws + WS_SSQP))
#define RSTDM ((float*)(ws + WS_MISC))
#define LAMT (RSTDM + 256)
#define GXT (RSTDM + 1024)
#define KMAX2 ((float*)(ws + WS_MISC + 32 * 1024))
#define KMAXP ((float*)(ws + WS_MISC + 64 * 1024))
#define ROPE128 ((float*)(ws + WS_ROPE128))
#define ROPE64 ((float*)(ws + WS_ROPE64))
#define LBP ((float*)(ws + WS_LBP))
#define BBT ((float*)(ws + WS_BBT))
#define S5MF ((bf16_t*)(ws + WS_S5MF))
#define S5EM ((bf16_t*)(ws + WS_S5E))
#define KMEM ((bf16_t*)(ws + WS_KMEM))
#define VMEMT ((bf16_t*)(ws + WS_VMEMT))
#define MEMB ((bf16_t*)(ws + WS_MEMB))
#define WGLU ((bf16_t*)(ws + WS_WGLU))
#define WIN ((bf16_t*)(ws + WS_WIN))
#define WOUT ((bf16_t*)(ws + WS_WOUT))
#define WQ ((bf16_t*)(ws + WS_WQ))
#define WK ((bf16_t*)(ws + WS_WK))
#define WV ((bf16_t*)(ws + WS_WV))
#define WO ((bf16_t*)(ws + WS_WO))
#define WFF1 ((bf16_t*)(ws + WS_WFF1))
#define WFF2 ((bf16_t*)(ws + WS_WFF2))
#define XB ((bf16_t*)(ws + WS_XB))
#define QA ((bf16_t*)(ws + WS_QA))
#define KA ((bf16_t*)(ws + WS_KA))
#define VA ((bf16_t*)(ws + WS_VA))
#define QI ((bf16_t*)(ws + WS_QI))
#define KI ((bf16_t*)(ws + WS_KI))
#define WI ((float*)(ws + WS_WI))
#define S5A ((bf16_t*)(ws + WS_S5A))
#define S5EO ((float*)(ws + WS_S5EO))
#define YB ((bf16_t*)(ws + WS_YB))
#define QC ((bf16_t*)(ws + WS_QC))
#define KC ((bf16_t*)(ws + WS_KC))
#define VC ((bf16_t*)(ws + WS_VC))
#define OD ((bf16_t*)(ws + WS_OD))
#define CAT ((bf16_t*)(ws + WS_CAT))
#define QX ((bf16_t*)(ws + WS_QX))
#define PX ((bf16_t*)(ws + WS_PX))
#define OX ((bf16_t*)(ws + WS_OX))
#define HID ((bf16_t*)(ws + WS_HID))
#define MASK ((unsigned*)(ws + WS_MASK))
#define XSA ((bf16_t*)(ws + WS_XSA))
#define XOB ((bf16_t*)(ws + WS_XOB))

    if (SITE(0) && IN(0)) {
        ENV();
            for (int rep = 0; rep < REPS(0); ++rep) {
            int tid_o = tid_of(W0()); asm volatile("" : "+v"(tid_o)); const int tid = tid_o, lane = tid & 63, wave = __builtin_amdgcn_readfirstlane(tid >> 6), gw = vcu * NWAVES + wave; (void)lane; (void)gw;
        LAS float* scr = (LAS float*)(lds + wave * 16640);
        constexpr int I_IN = 32 * 90, I_SQ = 32 * 32, I_F1 = 32 * 128, I_F2 = 128 * 32, I_GL = 8 * 8, PER_L = I_IN + 4 * I_SQ + I_F1 + I_F2 + I_GL;
        for (int it = gw; it < DEPTH * PER_L; it += NGW) {
            const int l = it / PER_L; int r = it % PER_L;
            if (r < I_IN) { transpose_item(w_in + (size_t)l * DM * NIN, DM, NIN, WIN + (size_t)l * NINP * DM, norm_mix + l * DM, 1, scr, r / 90, r % 90, lane); continue; } r -= I_IN;
            if (r < I_SQ) { transpose_item(w_out + (size_t)l * DM * DM, DM, DM, WOUT + (size_t)l * DM * DM, nullptr, 0, scr, r / 32, r % 32, lane); continue; } r -= I_SQ;
            if (r < I_SQ) { transpose_item(xk + (size_t)l * DM * DM, DM, DM, WK + (size_t)l * DM * DM, norm_mem + l * DM, 0, scr, r / 32, r % 32, lane); continue; } r -= I_SQ;
            if (r < I_SQ) { transpose_item(xv + (size_t)l * DM * DM, DM, DM, WV + (size_t)l * DM * DM, norm_mem + l * DM, 0, scr, r / 32, r % 32, lane); continue; } r -= I_SQ;
            if (r < I_SQ) { transpose_item(xo + (size_t)l * DM * DM, DM, DM, WO + (size_t)l * DM * DM, nullptr, 0, scr, r / 32, r % 32, lane); continue; } r -= I_SQ;
            if (r < I_F1) { transpose_item(w_ff1 + (size_t)l * DM * DFF, DM, DFF, WFF1 + (size_t)l * DFF * DM, norm_mlp + l * DM, 0, scr, r / 128, r % 128, lane); continue; } r -= I_F1;
            if (r < I_F2) { transpose_item(w_ff2 + (size_t)l * DFF * DM, DFF, DM, WFF2 + (size_t)l * DM * DFF, nullptr, 0, scr, r / 32, r % 32, lane); continue; } r -= I_F2;
            transpose_item(s5_w_glu + (size_t)l * 512 * 512, 512, 512, WGLU + (size_t)l * 512 * 512, nullptr, 0, scr, r / 8, r % 8, lane);
        }
        for (int row = gw; row < L + MEMT; row += NGW) {
            const bool ism = row >= L; const int rr = ism ? row - L : row;
            const f32x4* xr = (const f32x4*)((ism ? mem : x_in) + (size_t)rr * DM) + lane; u32x2* ob = (u32x2*)((ism ? MEMB : XB) + (size_t)rr * DM) + lane;
            float s = 0.f;
#pragma unroll
            for (int j = 0; j < 8; ++j) { const f32x4 v = xr[64 * j]; s += (v[0] * v[0] + v[1] * v[1]) + (v[2] * v[2] + v[3] * v[3]); u32x2 w; w.x = cvt_pk_bf16(v[0], v[1]); w.y = cvt_pk_bf16(v[2], v[3]); ob[64 * j] = w; }
            s = wave_sum(s);
            if (ism) { if (lane == 0) RSTDM[rr] = 1.0f / sqrtf(s * (1.0f / DM) + EPS); } else if (lane < 32) SSQ[(size_t)rr * 32 + lane] = lane == 0 ? s : 0.f;
        }
        for (int row = gw; row < DEPTH * DM; row += NGW) {
            const f32x4* xr = (const f32x4*)(xq + (size_t)row * DM) + lane; u32x2* ob = (u32x2*)(WQ + (size_t)row * DM) + lane;
#pragma unroll
            for (int j = 0; j < 8; ++j) { const f32x4 v = xr[64 * j]; u32x2 w; w.x = cvt_pk_bf16(v[0], v[1]); w.y = cvt_pk_bf16(v[2], v[3]); ob[64 * j] = w; }
        }
        const int gt = vcu * (NWAVES * 64) + tid, NGT = G * NWAVES * 64;
        for (int i = gt; i < DEPTH * DM; i += NGT) GXT[i] = norm_xattn[i] * SCL_X;
        for (int i = gt; i < L * 96; i += NGT) {
            int pos, fi, dim; float* dst;
            if (i < L * 64) { pos = i >> 6; fi = i & 63; dim = 128; dst = ROPE128 + (size_t)i * 2; } else { const int k = i - L * 64; pos = k >> 5; fi = k & 31; dim = 64; dst = ROPE64 + (size_t)k * 2; }
            const float ex = -(float)(2 * fi) / (float)dim;
            const float inv = (float)exp2((double)ex * 13.287712379549449);
            const float ang = (float)pos * inv;
            float c, s; cs_reduced((double)ang, c, s); dst[0] = c; dst[1] = s;
        }
        for (int i = gt; i < DEPTH * 32 * 64; i += NGT) {
            const int lg = i >> 6;
            const double dt = exp((double)s5_log_dt[lg]); const double are = (double)s5_a_re[i], aim = (double)s5_a_im[i];
            float* lp = LBP + (size_t)i * 34; float lre = 1.f, lim = 0.f;
            for (int tau = 0; tau <= 16; ++tau) { const float mag = expf((float)(are * dt * tau)); float c, s; cs_reduced(aim * dt * tau, c, s); lp[2 * tau] = mag * c; lp[2 * tau + 1] = mag * s; if (tau == 1) { lre = mag * c; lim = mag * s; } }
            const float ar = (float)are, ai = (float)aim, den = ar * ar + ai * ai;
            const float fre = ((lre - 1.0f) * ar + lim * ai) / den, fim = (lim * ar - (lre - 1.0f) * ai) / den;
            float* bp = BBT + (size_t)i * 32;
            for (int p = 0; p < 16; ++p) { const float br = s5_b_re[(size_t)i * 16 + p], bi = s5_b_im[(size_t)i * 16 + p]; bp[2 * p] = fre * br - fim * bi; bp[2 * p + 1] = fre * bi + fim * br; }
        }
        if (gt < DEPTH) {
            const int l = gt; float s1 = 0.f, s2 = 0.f;
            for (int d = 0; d < 64; ++d) { s1 += lam_q1[l * 64 + d] * lam_k1[l * 64 + d]; s2 += lam_q2[l * 64 + d] * lam_k2[l * 64 + d]; }
            const float lam_init = 0.8f - 0.6f * expf(-0.3f * (float)l);
            LAMT[l] = expf(s1) - expf(s2) + lam_init;
        }
            }
        SEAM(0);
    }
    if (SITE(1) && IN(1)) {
        ENV();
            for (int rep = 0; rep < REPS(1); ++rep) {
            int tid_o = tid_of(W0()); asm volatile("" : "+v"(tid_o)); const int tid = tid_o, lane = tid & 63, wave = __builtin_amdgcn_readfirstlane(tid >> 6), gw = vcu * NWAVES + wave; (void)lane; (void)gw;
        for (int it = (int)blockIdx.x; it < DEPTH * 32; it += G) {
            LAS float* T_lbp = (LAS float*)lds;
            LAS float* T_bb = T_lbp + 64 * 34;
            LAS float* T_c = T_bb + 64 * 32;
            LAS float* T_k = T_c + 16 * 128;
            __syncthreads();
            for (int i = tid; i < 64 * 34; i += 512) T_lbp[i] = LBP[(size_t)it * 64 * 34 + i];
            for (int i = tid; i < 64 * 32; i += 512) T_bb[i] = BBT[(size_t)it * 64 * 32 + i];
            for (int i = tid; i < 16 * 64; i += 512) { T_c[2 * i] = s5_c_re[(size_t)it * 1024 + i]; T_c[2 * i + 1] = s5_c_im[(size_t)it * 1024 + i]; }
            __syncthreads();
            for (int e = tid; e < 4096; e += 512) {
                const int tau = e >> 8, p = (e >> 4) & 15, q = e & 15; float acc = 0.f;
                for (int n = 0; n < 64; ++n) {
                    const float cr = T_c[(p * 64 + n) * 2], ci = T_c[(p * 64 + n) * 2 + 1], lr = T_lbp[(n * 17 + tau) * 2], li = T_lbp[(n * 17 + tau) * 2 + 1], br = T_bb[(n * 16 + q) * 2], bi = T_bb[(n * 16 + q) * 2 + 1];
                    const float tr = cr * lr - ci * li, ti = cr * li + ci * lr;
                    acc += tr * br - ti * bi;
                }
                if (tau == 0 && p == q) acc += s5_d[(size_t)it * 16 + p];
                T_k[e] = acc;
            }
            __syncthreads();
            bf16_t* mf = S5MF + (size_t)it * 256 * 384;
            for (int ch = tid; ch < 256 * 48; ch += 512) {
                const int row = ch / 48, c0 = (ch % 48) * 8, s = row >> 4, p = row & 15; float v[8];
                if (c0 < 256) { const int sp = c0 >> 4, q0 = c0 & 15;
#pragma unroll
                    for (int e = 0; e < 8; ++e) v[e] = (sp <= s) ? T_k[((s - sp) * 16 + p) * 16 + q0 + e] : 0.f; }
                else { const bool im = c0 >= 320; const int n0 = (c0 - 256) & 63;
#pragma unroll
                    for (int e = 0; e < 8; ++e) { const int n = n0 + e; const float cr = T_c[(p * 64 + n) * 2], ci = T_c[(p * 64 + n) * 2 + 1], lr = T_lbp[(n * 17 + s + 1) * 2], li = T_lbp[(n * 17 + s + 1) * 2 + 1];
                        v[e] = im ? -(cr * li + ci * lr) : (cr * lr - ci * li); } }
                u32x4 o; o.x = cvt_pk_bf16(v[0], v[1]); o.y = cvt_pk_bf16(v[2], v[3]); o.z = cvt_pk_bf16(v[4], v[5]); o.w = cvt_pk_bf16(v[6], v[7]);
                *(u32x4*)(mf + (size_t)row * 384 + c0) = o;
            }
            bf16_t* em = S5EM + (size_t)it * 256 * 256;
            for (int ch = tid; ch < 128 * 32; ch += 512) {
                const int row = ch >> 5, c0 = (ch & 31) * 8, n = row & 63, sp = c0 >> 4, q0 = c0 & 15; const bool im = row >= 64; float v[8];
                const float lr = T_lbp[(n * 17 + 15 - sp) * 2], li = T_lbp[(n * 17 + 15 - sp) * 2 + 1];
#pragma unroll
                for (int e = 0; e < 8; ++e) { const float br = T_bb[(n * 16 + q0 + e) * 2], bi = T_bb[(n * 16 + q0 + e) * 2 + 1]; v[e] = im ? (lr * bi + li * br) : (lr * br - li * bi); }
                u32x4 o; o.x = cvt_pk_bf16(v[0], v[1]); o.y = cvt_pk_bf16(v[2], v[3]); o.z = cvt_pk_bf16(v[4], v[5]); o.w = cvt_pk_bf16(v[6], v[7]);
                *(u32x4*)(em + (size_t)row * 256 + c0) = o;
            }
        }
        __syncthreads();
        {
            pg8::Sched S{(const char*)MEMB, (const char*)WK, 0, (long)DM * DM * 2, DM, DM, 1, 8, DEPTH, G, (int)((blockIdx.x + G - G / 2) % G)};
            pg8::EpiMemKV<false> E{RSTDM, KMEM, DM, (long)MEMT * DM};
            pg8::gemm_phase<pg8::EpiMemKV<false>>(lds, DM, S, E, W0());
        }
        {
            pg8::Sched S{(const char*)MEMB, (const char*)WV, 0, (long)DM * DM * 2, DM, DM, 1, 8, DEPTH, G, (int)((blockIdx.x + G - (G / 2 + 32)) % G)};
            pg8::EpiMemKV<false> E{RSTDM, VMEMT, DM, (long)MEMT * DM};
            pg8::gemm_phase<pg8::EpiMemKV<false>>(lds, DM, S, E, W0());
        }
            }
        SEAM(1);
    }
    if (SITE(12) && IN(2)) {
        ENV();
#pragma unroll 1
        for (int l2 = 0; l2 < DEPTH; ++l2) {
            {   pg8::Sched S{(const char*)(KMEM + (size_t)l2 * MEMT * DM), (const char*)(WQ + (size_t)l2 * DM * DM), 512 * 2, 512 * 2, DM, DM, 1, 8, 4, G, (int)((blockIdx.x + G - 32 * l2) % G)};
                pg8::EpiMemKV<true> E{GXT + l2 * DM, XSA + (size_t)l2 * 1024 * DM, DM, (long)MEMT * DM};
                pg8::gemm_phase<pg8::EpiMemKV<true>>(lds, 512, S, E, W0()); }
            {   pg8::Sched S{(const char*)(WO + (size_t)l2 * DM * DM), (const char*)(VMEMT + (size_t)l2 * MEMT * DM), 512 * 2, 512 * 2, DM, DM, 8, 1, 4, G, (int)((blockIdx.x + G - (128 + 32 * l2)) % G)};
                pg8::EpiMemKV<false> E{nullptr, XOB + (size_t)l2 * DM * 1024, 1024, (long)MEMT};
                pg8::gemm_phase<pg8::EpiMemKV<false>>(lds, 512, S, E, W0()); }
        }
        SEAM(2);
    }

    for (int l = 0; l < DEPTH; ++l) {
        const int sb = NSTEP_PRO + l * NSTEP_LAYER;
#define ssq_mix (SSQ + (size_t)(3 * l) * L * 32)
#define ssq_x (SSQ + (size_t)(3 * l + 1) * L * 32)
#define ssq_mlp (SSQ + (size_t)(3 * l + 2) * L * 32)
#define ssq_nxt (SSQ + (size_t)(3 * l + 3) * L * 32)

        if (SITE(2) && IN(sb + 0)) {
            ENV();
            for (int rep = 0; rep < REPS(2); ++rep) {
            pg8::Sched S{(const char*)XB, (const char*)(WIN + (size_t)l * NINP * DM), 0, 0, DM, DM, L / 256, NINP / 256, 1, G, (int)blockIdx.x};
            pg8::EpiInProj E{ssq_mix, ROPE128, ROPE64, QA, KA, VA, QI, KI, S5A, QC, KC, VC, WI, (LAS float*)(lds + EPI_OFF), KMAXP + (size_t)l * 20 * 512};
            pg8::gemm_phase<pg8::EpiInProj>(lds, DM, S, E, W0());
            }
            SEAM(sb + 0);
        }
        if (SITE(3) && IN(sb + 1)) {
            ENV();
            for (int rep = 0; rep < REPS(3); ++rep) {
            if ((int)blockIdx.x >= G - 20) {
                const int slot = (int)blockIdx.x - (G - 20); int t = tid_of(W0()); asm volatile("" : "+v"(t)); LAS float* red = (LAS float*)(lds + EPI_OFF);
                float v = (t < (slot < 16 ? 256 : 512)) ? KMAXP[((size_t)l * 20 + slot) * 512 + t] : 0.f;
                v = wave_max(v); if ((t & 63) == 0) red[t >> 6] = v;
                __syncthreads();
                if (t == 0) { float m = red[0]; for (int i = 1; i < 8; ++i) m = fmaxf(m, red[i]); KMAX2[l * 32 + slot] = m; }
                __syncthreads();
            }
            for (int pi = vcu; pi < 512; pi += G) {
#pragma unroll 1
                for (int k = 0; k < 2; ++k) { const int b = k ? pi : 1023 - pi; dsa::select_block(b * 16, QI, KI, WI, MASK, lds, W0()); }
            }
            }
            SEAM(sb + 1);
        }
        if (SITE(4) && IN(sb + 2)) {
            ENV();
            for (int rep = 0; rep < REPS(4); ++rep) {
            {
            int tid_o = tid_of(W0()); asm volatile("" : "+v"(tid_o)); const int tid = tid_o, lane = tid & 63, wave = __builtin_amdgcn_readfirstlane(tid >> 6), gw = vcu * NWAVES + wave; (void)lane; (void)gw;
            for (int g = vcu; g < 32; g += G) {
                if (SITE(3)) {
                    pg8::Sched S{(const char*)S5A, (const char*)(S5EM + (size_t)l * 32 * 256 * 256), (long)1024 * 384 * 2, (long)256 * 256 * 2, 384, 256, 4, 1, 32, G, 0, 4, 0, 0, g, 1};
                    pg8::EpiS5E E{S5EO};
                    pg8::gemm_phase<pg8::EpiS5E>(lds, 256, S, E, W0());
                }
                asm volatile("s_waitcnt vmcnt(0)" ::: "memory");
                __syncthreads();
                const int n = tid & 63, seg = tid >> 6;
                LAS float* segend = (LAS float*)lds;
                const float* lp = LBP + ((size_t)(l * 32 + g) * 64 + n) * 34;
                const float ar = lp[32], ai = lp[33];
                const float* ep = S5EO + ((size_t)g * 1024 + seg * 128) * 128 + n;
                float xr = 0.f, xi = 0.f;
#pragma unroll 1
                for (int j0 = 0; j0 < 128; j0 += 16) {
                    float er_[16], ei_[16];
#pragma unroll
                    for (int u = 0; u < 16; ++u) { er_[u] = ep[(size_t)(j0 + u) * 128]; ei_[u] = ep[(size_t)(j0 + u) * 128 + 64]; }
#pragma unroll
                    for (int u = 0; u < 16; ++u) { const float nr = ar * xr - ai * xi + er_[u], ni = ar * xi + ai * xr + ei_[u]; xr = nr; xi = ni; }
                }
                __syncthreads();
                segend[(seg * 64 + n) * 2] = xr; segend[(seg * 64 + n) * 2 + 1] = xi;
                __syncthreads();
                float pr = ar, pi = ai;
#pragma unroll
                for (int q = 0; q < 7; ++q) { const float nr = pr * pr - pi * pi, ni = 2.f * pr * pi; pr = nr; pi = ni; }
                xr = 0.f; xi = 0.f;
                for (int s2 = 0; s2 < seg; ++s2) { const float er = segend[(s2 * 64 + n) * 2], ei = segend[(s2 * 64 + n) * 2 + 1]; const float nr = pr * xr - pi * xi + er, ni = pr * xi + pi * xr + ei; xr = nr; xi = ni; }
                bf16_t* xp = S5A + ((size_t)g * 1024 + seg * 128) * 384 + 256 + n;
#pragma unroll 1
                for (int j0 = 0; j0 < 128; j0 += 16) {
                    float er_[16], ei_[16];
#pragma unroll
                    for (int u = 0; u < 16; ++u) { er_[u] = ep[(size_t)(j0 + u) * 128]; ei_[u] = ep[(size_t)(j0 + u) * 128 + 64]; }
#pragma unroll
                    for (int u = 0; u < 16; ++u) { const int j = j0 + u;
                        xp[(size_t)j * 384] = (bf16_t)(cvt_pk_bf16(xr, 0.f) & 0xffffu); xp[(size_t)j * 384 + 64] = (bf16_t)(cvt_pk_bf16(xi, 0.f) & 0xffffu);
                        const float nr = ar * xr - ai * xi + er_[u], ni = ar * xi + ai * xr + ei_[u]; xr = nr; xi = ni; }
                }
                asm volatile("s_waitcnt vmcnt(0)" ::: "memory");
                __syncthreads();
                if (SITE(5)) {
                    pg8::Sched S{(const char*)S5A, (const char*)(S5MF + (size_t)l * 32 * 256 * 384), (long)1024 * 384 * 2, (long)256 * 384 * 2, 384, 384, 4, 1, 32, G, 0, 4, 0, 0, g, 1};
                    pg8::EpiS5Y E{YB};
                    pg8::gemm_phase<pg8::EpiS5Y>(lds, 384, S, E, W0());
                }
                asm volatile("s_waitcnt vmcnt(0)" ::: "memory");
                __syncthreads();
                if (tid == 0) { __builtin_amdgcn_fence(__ATOMIC_RELEASE, "agent"); (void)xb_add(ctl + CW_Q + 64 * l + 48, 1u); }
            }
            }
            LAS unsigned* qw = (LAS unsigned*)(lds + LDSCTL_OFF);
            unsigned* qhead = ctl + CW_Q + 64 * l + 16 * rep;
            bool s5_ok = false;
#pragma unroll 1
            for (;;) {
                __syncthreads();
                if (tid_of(W0()) == 0) *qw = __hip_atomic_fetch_add(qhead, 1u, __ATOMIC_RELAXED, __HIP_MEMORY_SCOPE_AGENT);
                __syncthreads();
                const unsigned ui = (unsigned)__builtin_amdgcn_readfirstlane((int)*qw);
                if (ui >= 768u + 128u) break;
                if (ui >= 768u) {
                    if (!s5_ok) {
                        if (tid_of(W0()) == 0) { unsigned* sc_ = ctl + CW_Q + 64 * l + 48; XB_SPIN(xb_ld(sc_) < 32u * (unsigned)(rep + 1), ctl + CW_BAR); __builtin_amdgcn_fence(__ATOMIC_ACQUIRE, "agent"); }
                        __syncthreads(); s5_ok = true;
                    }
                    if (SITE(6)) {
                        const int idx = (int)ui - 768;
                        pg8::Sched S{(const char*)YB, (const char*)(WGLU + (size_t)l * 512 * 512), 0, 0, 512, 512, L / 256, 2, 1, G, 0, 1, idx >> 1, idx & 1, 0};
                        pg8::EpiGLU E{YB, s5_b_glu + l * 512, CAT};
                        pg8::gemm_phase<pg8::EpiGLU>(lds, 512, S, E, W0());
                    }
                    continue;
                }
                const int qb = 63 - (int)(ui / 12u), j = (int)(ui % 12u);
                if (j >= 8) { const int h = j - 8; const float km2 = KMAX2[l * 32 + 16 + h];
                    if (dattn::attn_unit<128, true, true, 0>(QA + h * 128, KA + h * 128, VA + h * 128, CAT + h * 128, MASK, 512, 512, qb * 256, (char*)lds_raw, km2, W0()))
                        (void)dattn::attn_unit<128, true, false, 0>(QA + h * 128, KA + h * 128, VA + h * 128, CAT + h * 128, MASK, 512, 512, qb * 256, (char*)lds_raw, km2, W0()); }
                else {
                    const float lam = LAMT[l], post = 1.0f - (0.8f - 0.6f * expf(-0.3f * (float)l));
                    { const int hh = 2 * j; const float km2 = KMAX2[l * 32 + hh];
                      if (dattn::attn_unit<64, false, true, 1>(QC + hh * 64, KC + hh * 64, VC + j * 128, nullptr, nullptr, 1024, 1024, qb * 256, (char*)lds_raw, km2, W0()))
                          dattn::attn_unit<64, false, false, 1>(QC + hh * 64, KC + hh * 64, VC + j * 128, nullptr, nullptr, 1024, 1024, qb * 256, (char*)lds_raw, km2, W0()); }
                    { const int hh = 2 * j + 1; const float km2 = KMAX2[l * 32 + hh];
                      if (dattn::attn_unit<64, false, true, 2>(QC + hh * 64, KC + hh * 64, VC + j * 128, CAT + 1024 + j * 128, nullptr, 1024, 1024, qb * 256, (char*)lds_raw, km2, W0(), lam, post, subln + l * 128))
                          dattn::attn_unit<64, false, false, 2>(QC + hh * 64, KC + hh * 64, VC + j * 128, CAT + 1024 + j * 128, nullptr, 1024, 1024, qb * 256, (char*)lds_raw, km2, W0(), lam, post, subln + l * 128); }
                }
            }
            }
            SEAM(sb + 2);
        }
        if (SITE(7) && IN(sb + 3)) {
            ENV();
            for (int rep = 0; rep < REPS(7); ++rep) {
            pg8::Sched S{(const char*)CAT, (const char*)(WOUT + (size_t)l * DM * DM), 0, 0, DM, DM, L / 256, DM / 256, 1, G, (int)blockIdx.x};
            pg8::EpiResid E{XB, ssq_x};
            pg8::gemm_phase<pg8::EpiResid>(lds, DM, S, E, W0());
            }
            SEAM(sb + 3);
        }
        if (SITE(8) && IN(sb + 4)) {
            ENV();
            for (int rep = 0; rep < REPS(8); ++rep) {
            pg8::Sched S{(const char*)XB, (const char*)(XSA + (size_t)l * 1024 * DM), 0, (long)MEMT * DM * 2, DM, DM, L / 256, 1, 4, G, (int)blockIdx.x};
            pg8::EpiSoftmax E{ssq_x, PX, (LAS float*)(lds + EPI_OFF)};
            pg8::gemm_phase<pg8::EpiSoftmax>(lds, DM, S, E, W0());
            }
            SEAM(sb + 4);
        }
        if (SITE(9) && IN(sb + 5)) {
            ENV();
            for (int rep = 0; rep < REPS(9); ++rep) {
            pg8::Sched S{(const char*)PX, (const char*)(XOB + (size_t)l * DM * 1024), 0, 0, 1024, 1024, L / 256, DM / 256, 1, G, (int)blockIdx.x};
            pg8::EpiResid E{XB, ssq_mlp};
            pg8::gemm_phase<pg8::EpiResid>(lds, 1024, S, E, W0());
            }
            SEAM(sb + 5);
        }
        if (SITE(10) && IN(sb + 6)) {
            ENV();
            for (int rep = 0; rep < REPS(10); ++rep) {
            pg8::Sched S{(const char*)XB, (const char*)(WFF1 + (size_t)l * DFF * DM), 0, 0, DM, DM, L / 256, DFF / 256, 1, G, (int)blockIdx.x};
            pg8::EpiRowBf16<1> E{ssq_mlp, HID, DFF, 0, (LAS float*)(lds + EPI_OFF)};
            pg8::gemm_phase<pg8::EpiRowBf16<1>>(lds, DM, S, E, W0());
            }
            SEAM(sb + 6);
        }
        if (SITE(11) && IN(sb + 7)) {
            ENV();
            for (int rep = 0; rep < REPS(11); ++rep) {
            pg8::Sched S{(const char*)HID, (const char*)(WFF2 + (size_t)l * DM * DFF), 0, 0, DFF, DFF, L / 256, DM / 256, 1, G, (int)blockIdx.x};
            pg8::EpiResid E{XB, ssq_nxt};
            pg8::gemm_phase<pg8::EpiResid>(lds, DFF, S, E, W0());
            }
            SEAM(sb + 7);
        }
    }
    if (SITE(15) && IN(NSTEPS - 1)) {
        ENV();
            int tid_o = tid_of(W0()); asm volatile("" : "+v"(tid_o)); const int tid = tid_o, lane = tid & 63, wave = __builtin_amdgcn_readfirstlane(tid >> 6), gw = vcu * NWAVES + wave; (void)lane; (void)gw;
        const float* sq = SSQ + (size_t)(3 * DEPTH) * L * 32;
        for (int row = gw; row < L; row += NGW) {
            const float rs = 1.0f / sqrtf(pg8::ssq32(sq + (size_t)row * 32) * (1.0f / DM) + EPS);
            const u32x2* xr = (const u32x2*)(XB + (size_t)row * DM) + lane; f32x4* orow = (f32x4*)(xres + (size_t)row * DM) + lane; const f32x4* gp = (const f32x4*)norm_final + lane;
#pragma unroll
            for (int j = 0; j < 8; ++j) { const u32x2 w = xr[64 * j]; const f32x4 v = {bflo(w.x), bfhi(w.x), bflo(w.y), bfhi(w.y)}; orow[64 * j] = v * rs * gp[64 * j]; }
        }
    }
#undef IN
#undef SEAM
}

#ifndef MK_PER_STEP
#define MK_PER_STEP 0
#endif
extern "C" void kernel_launch(void* const* d_in, const int* in_sizes, int n_in, void* d_out, int out_size, void* d_ws, size_t ws_size, hipStream_t stream) {
    static int grid = 0;
    if (grid == 0) {
        if (n_in != 30 || in_sizes[0] != L * DM || out_size != L * DM || ws_size < WS_END) { fprintf(stderr, "kernel_launch: unexpected shapes (n_in %d, in0 %d, out %d, ws %zu < %zu)\n", n_in, n_in > 0 ? in_sizes[0] : -1, out_size, ws_size, (size_t)WS_END); grid = -1; return; }
        int dev = 0, cus = 0, per_cu = 0;
        if (hipGetDevice(&dev) != hipSuccess || hipDeviceGetAttribute(&cus, hipDeviceAttributeMultiprocessorCount, dev) != hipSuccess) { grid = -1; return; }
        if (hipFuncSetAttribute((const void*)fwd_kernel, hipFuncAttributeMaxDynamicSharedMemorySize, LDS_BYTES) != hipSuccess) { fprintf(stderr, "kernel_launch: hipFuncSetAttribute failed\n"); grid = -1; return; }
        if (hipOccupancyMaxActiveBlocksPerMultiprocessor(&per_cu, (const void*)fwd_kernel, NWAVES * 64, LDS_BYTES) != hipSuccess || per_cu < 1) fprintf(stderr, "kernel_launch: occupancy query reports %d\n", per_cu);
        (void)hipGetLastError();
        grid = cus;
    }
    if (grid < 0) return;
    (void)hipMemsetAsync((char*)d_ws, 0, ZERO_BYTES, stream);
    Args a{};
    for (int i = 0; i < 30; ++i) a.in[i] = (const float*)d_in[i];
    a.out = (float*)d_out; a.ws = (unsigned char*)d_ws;
#if MK_PER_STEP
    for (int s = 0; s < NSTEPS; ++s) { a.ph_lo = s; a.ph_hi = s + 1; hipLaunchKernelGGL(fwd_kernel, dim3(grid), dim3(NWAVES * 64), LDS_BYTES, stream, a); }
#else
    a.ph_lo = 0; a.ph_hi = NSTEPS; hipLaunchKernelGGL(fwd_kernel, dim3(grid), dim3(NWAVES * 64), LDS_BYTES, stream, a);
#endif
    const hipError_t le = hipPeekAtLastError();
    if (le != hipSuccess) fprintf(stderr, "kernel_launch: launch failed: %s\n", hipGetErrorName(le));
}
```
